# Optimizing an MI355X kernel written in HIP

```python
import math
import jax, jax.numpy as jnp
from jax import lax
import numpy as np

D_MODEL = 1024
BATCH = 2
SEQ = 16384
DEPTH = 4

CHUNK = 64
MEM_LEN = 256
D_MIX = D_MODEL
SSD_WIDTH = D_MIX // 2
SSD_HEAD_DIM = 64
SSD_HEADS = SSD_WIDTH // SSD_HEAD_DIM
SSD_GROUPS = 2
SSD_STATE = 128
SSD_CONV = 4
SSD_CONV_CH = SSD_WIDTH + 2 * SSD_GROUPS * SSD_STATE
FOX_WIDTH = D_MIX // 4
FOX_HEAD_DIM = 64
FOX_HEADS = FOX_WIDTH // FOX_HEAD_DIM
FOX_BLOCK = 128
POOL_WIDTH = D_MIX - SSD_WIDTH - FOX_WIDTH
POOL_WINDOWS = (2, 4, 8, 16)
POOL_GROUPS = len(POOL_WINDOWS)
POOL_GROUP_DIM = POOL_WIDTH // POOL_GROUPS
IN_SIZES = (SSD_WIDTH, SSD_CONV_CH, SSD_HEADS, FOX_WIDTH, FOX_WIDTH, FOX_WIDTH, FOX_HEADS, POOL_WIDTH)
D_IN = sum(IN_SIZES)
XATTN_HEADS = 4
XATTN_HEAD_DIM = D_MODEL // XATTN_HEADS
D_FF = 7 * D_MODEL // 2
N_EXPERTS = 8
TOP_K = 2
MOE_BLOCK = 256
N_DENSE = (DEPTH + 1) // 2
N_MOE = DEPTH // 2
DN_ALPHA = (2 * DEPTH) ** 0.25
DN_BETA = (8 * DEPTH) ** -0.25
LN_EPS = 1e-5
RMS_EPS = 1e-5

kernel_name = "hybrid_ssd_fox_pool_moe_deepnorm"


def layer_norm(x, g, b):
    xf = x.astype(jnp.float32)
    mu = jnp.mean(xf, axis=-1, keepdims=True)
    var = jnp.mean(jnp.square(xf - mu), axis=-1, keepdims=True)
    return ((xf - mu) * lax.rsqrt(var + LN_EPS) * g + b).astype(x.dtype)


def split_in(h):
    outs, off = [], 0
    for s in IN_SIZES:
        outs.append(h[..., off:off + s])
        off += s
    return outs


def causal_depthwise_conv(u, w, b):
    K, T = w.shape[0], u.shape[1]
    up = jnp.pad(u, ((0, 0), (K - 1, 0), (0, 0)))
    return sum(up[:, k:k + T] * w[k] for k in range(K)) + b


def ssd_mixer(z, xbc, dt_raw, conv_w, conv_b, dt_bias, a_log, d_skip, norm_w):
    Bsz, T, _ = z.shape
    G, R, P, N, L = SSD_GROUPS, SSD_HEADS // SSD_GROUPS, SSD_HEAD_DIM, SSD_STATE, CHUNK
    nc = T // L
    xbc = jax.nn.silu(causal_depthwise_conv(xbc, conv_w, conv_b))
    xs = xbc[..., :SSD_WIDTH]
    bm = xbc[..., SSD_WIDTH:SSD_WIDTH + G * N].reshape(Bsz, nc, L, G, N)
    cm = xbc[..., SSD_WIDTH + G * N:].reshape(Bsz, nc, L, G, N)
    dt = jax.nn.softplus(dt_raw.astype(jnp.float32) + dt_bias)
    a = -jnp.exp(a_log.astype(jnp.float32))
    X = xs.reshape(Bsz, nc, L, G, R, P) * dt.reshape(Bsz, nc, L, G, R)[..., None]
    A = (dt * a).reshape(Bsz, nc, L, G, R).transpose(0, 3, 4, 1, 2)
    a_cs = jnp.cumsum(A, axis=-1)
    seg = a_cs[..., :, None] - a_cs[..., None, :]
    causal = jnp.tril(jnp.ones((L, L), dtype=bool))
    Lmat = jnp.exp(jnp.where(causal, seg, -jnp.inf))
    cb = jnp.einsum('bclgn,bcsgn->bcgls', cm, bm)
    y_diag = jnp.einsum('bcgls,bgrcls,bcsgrp->bclgrp', cb, Lmat, X)
    decay_states = jnp.exp(a_cs[..., -1:] - a_cs)
    states = jnp.einsum('bclgn,bgrcl,bclgrp->bcgrpn', bm, decay_states, X)
    chunk_decay = jnp.exp(a_cs[..., -1])

    def step(h, inp):
        s_c, d_c = inp
        return h * d_c[..., None, None] + s_c, h

    h0 = jnp.zeros((Bsz, G, R, P, N), states.dtype)
    _, prev = lax.scan(step, h0, (jnp.moveaxis(states, 1, 0), jnp.moveaxis(chunk_decay, -1, 0)))
    prev = jnp.moveaxis(prev, 0, 1)
    y_off = jnp.einsum('bclgn,bcgrpn,bgrcl->bclgrp', cm, prev, jnp.exp(a_cs))
    y = (y_diag + y_off).reshape(Bsz, T, SSD_HEADS, P) + xs.reshape(Bsz, T, SSD_HEADS, P) * d_skip[:, None]
    y = y.reshape(Bsz, T, SSD_WIDTH) * jax.nn.silu(z)
    yg = y.reshape(Bsz, T, G, SSD_WIDTH // G).astype(jnp.float32)
    yg = yg * lax.rsqrt(jnp.mean(jnp.square(yg), axis=-1, keepdims=True) + RMS_EPS)
    return (yg.reshape(Bsz, T, SSD_WIDTH) * norm_w).astype(z.dtype)


def fox_mixer(q, k, v, f_logit, f_bias):
    Bsz, T, _ = q.shape
    H, Dh = FOX_HEADS, FOX_HEAD_DIM
    q = q.reshape(Bsz, T, H, Dh).transpose(0, 2, 1, 3)
    k = k.reshape(Bsz, T, H, Dh).transpose(0, 2, 1, 3)
    v = v.reshape(Bsz, T, H, Dh).transpose(0, 2, 1, 3)
    log_f = jax.nn.log_sigmoid(f_logit.astype(jnp.float32) + f_bias)
    c = jnp.cumsum(log_f, axis=1).transpose(0, 2, 1)
    nq = T // FOX_BLOCK
    q_blocks = q.reshape(Bsz, H, nq, FOX_BLOCK, Dh).transpose(2, 0, 1, 3, 4)
    c_blocks = c.reshape(Bsz, H, nq, FOX_BLOCK).transpose(2, 0, 1, 3)
    key_pos = jnp.arange(T)
    scale = Dh ** -0.5

    def block(args):
        qb, cq, i = args
        q_pos = i * FOX_BLOCK + jnp.arange(FOX_BLOCK)
        s = jnp.einsum('bhqd,bhkd->bhqk', qb, k).astype(jnp.float32) * scale
        s = s + cq[..., :, None] - c[:, :, None, :]
        s = jnp.where(key_pos[None, :] <= q_pos[:, None], s, -jnp.inf)
        p = jax.nn.softmax(s, axis=-1)
        return jnp.einsum('bhqk,bhkd->bhqd', p.astype(v.dtype), v)

    out = lax.map(block, (q_blocks, c_blocks, jnp.arange(nq)))
    return out.transpose(1, 0, 3, 2, 4).reshape(Bsz, T, FOX_WIDTH)


def pool_mixer(u, w, b, scale):
    Bsz, T, _ = u.shape
    ug = u.reshape(Bsz, T, POOL_GROUPS, POOL_GROUP_DIM).astype(jnp.float32)
    cs = jnp.cumsum(ug, axis=1)
    means = []
    for g, win in enumerate(POOL_WINDOWS):
        c_g = cs[:, :, g]
        lagged = jnp.pad(c_g, ((0, 0), (win, 0), (0, 0)))[:, :T]
        count = jnp.minimum(jnp.arange(1, T + 1), win).astype(jnp.float32)[None, :, None]
        means.append((c_g - lagged) / count)
    pooled = jnp.stack(means, axis=2) - ug
    y = jnp.einsum('btgc,gcd->btgd', pooled, w) + b
    return (y.reshape(Bsz, T, POOL_WIDTH) * scale).astype(u.dtype)


def cross_attention(x, mem, wq, wk, wv, wo):
    Bsz, T, D = x.shape
    M = mem.shape[1]
    q = (x @ wq).reshape(Bsz, T, XATTN_HEADS, XATTN_HEAD_DIM)
    k = (mem @ wk).reshape(Bsz, M, XATTN_HEADS, XATTN_HEAD_DIM)
    v = (mem @ wv).reshape(Bsz, M, XATTN_HEADS, XATTN_HEAD_DIM)
    s = jnp.einsum('bqhd,bkhd->bhqk', q, k).astype(jnp.float32) * XATTN_HEAD_DIM ** -0.5
    p = jax.nn.softmax(s, axis=-1)
    o = jnp.einsum('bhqk,bkhd->bqhd', p.astype(v.dtype), v).reshape(Bsz, T, D)
    return o @ wo


def swiglu(x, w1, w3, w2):
    return (jax.nn.silu(x @ w1) * (x @ w3)) @ w2


def moe_swiglu(x, router_w, w1, w3, w2):
    Bsz, T, D = x.shape
    xf = x.reshape(-1, D)
    N = xf.shape[0]
    NK = N * TOP_K
    logits = (xf @ router_w).astype(jnp.float32)
    top_val, top_idx = lax.top_k(logits, TOP_K)
    gates = jax.nn.softmax(top_val, axis=-1)
    flat_e = top_idx.reshape(-1)
    flat_tok = jnp.arange(NK) // TOP_K
    flat_g = gates.reshape(-1)
    order = jnp.argsort(flat_e)
    sorted_e = flat_e[order]
    counts = jnp.zeros((N_EXPERTS,), jnp.int32).at[flat_e].add(1)
    padded = (counts + MOE_BLOCK - 1) // MOE_BLOCK * MOE_BLOCK
    start = jnp.cumsum(counts) - counts
    pend = jnp.cumsum(padded)
    pstart = pend - padded
    dest = pstart[sorted_e] + (jnp.arange(NK) - start[sorted_e])
    cap = -(-NK // MOE_BLOCK) * MOE_BLOCK + N_EXPERTS * MOE_BLOCK
    nblk = cap // MOE_BLOCK
    slot_tok = jnp.zeros((cap,), jnp.int32).at[dest].set(flat_tok[order])
    slot_gate = jnp.zeros((cap,), jnp.float32).at[dest].set(flat_g[order])
    block_exp = jnp.minimum(jnp.searchsorted(pend, jnp.arange(nblk) * MOE_BLOCK, side='right'), N_EXPERTS - 1)
    xs = xf[slot_tok].reshape(nblk, MOE_BLOCK, D)

    def run(args):
        xb, e = args
        return swiglu(xb, w1[e], w3[e], w2[e])

    ys = lax.map(run, (xs, block_exp)).reshape(cap, D)
    contrib = (ys * slot_gate[:, None]).astype(x.dtype)
    out = jnp.zeros((N, D), x.dtype).at[slot_tok].add(contrib)
    return out.reshape(Bsz, T, D)


def setup_inputs(seed: int = 0) -> dict:
    key = jax.random.key(seed)
    ks = iter(jax.random.split(key, 40))
    nrm = lambda shape, s: jax.random.normal(next(ks), shape, jnp.float32) * s
    x = nrm((BATCH, SEQ, D_MODEL), 1.0)
    mem = nrm((BATCH, MEM_LEN, D_MODEL), 1.0)
    w_in = nrm((DEPTH, D_MODEL, D_IN), D_MODEL ** -0.5)
    ssm_conv_w = nrm((DEPTH, SSD_CONV, SSD_CONV_CH), SSD_CONV ** -0.5)
    ssm_conv_b = nrm((DEPTH, SSD_CONV_CH), 0.02)
    u = jax.random.uniform(next(ks), (DEPTH, SSD_HEADS), jnp.float32)
    dt0 = jnp.exp(u * (math.log(0.1) - math.log(0.001)) + math.log(0.001))
    ssm_dt_bias = dt0 + jnp.log(-jnp.expm1(-dt0))
    ssm_a_log = jnp.log(jax.random.uniform(next(ks), (DEPTH, SSD_HEADS), jnp.float32, 1.0, 16.0))
    ssm_d = 1.0 + nrm((DEPTH, SSD_HEADS), 0.1)
    ssm_norm_w = 1.0 + nrm((DEPTH, SSD_WIDTH), 0.02)
    fox_f_bias = jax.random.uniform(next(ks), (DEPTH, FOX_HEADS), jnp.float32, 2.0, 7.0)
    pool_w = nrm((DEPTH, POOL_GROUPS, POOL_GROUP_DIM, POOL_GROUP_DIM), POOL_GROUP_DIM ** -0.5)
    pool_b = nrm((DEPTH, POOL_GROUPS, POOL_GROUP_DIM), 0.02)
    pool_scale = 1.0 + nrm((DEPTH, POOL_WIDTH), 0.1)
    w_out = nrm((DEPTH, D_MIX, D_MODEL), D_MIX ** -0.5 * DN_BETA)
    ln1_g = 1.0 + nrm((DEPTH, D_MODEL), 0.02)
    ln1_b = nrm((DEPTH, D_MODEL), 0.02)
    xa_wq = nrm((DEPTH, D_MODEL, D_MODEL), D_MODEL ** -0.5)
    xa_wk = nrm((DEPTH, D_MODEL, D_MODEL), D_MODEL ** -0.5)
    xa_wv = nrm((DEPTH, D_MODEL, D_MODEL), D_MODEL ** -0.5)
    xa_wo = nrm((DEPTH, D_MODEL, D_MODEL), D_MODEL ** -0.5 * DN_BETA)
    ln2_g = 1.0 + nrm((DEPTH, D_MODEL), 0.02)
    ln2_b = nrm((DEPTH, D_MODEL), 0.02)
    ffn_w1 = nrm((N_DENSE, D_MODEL, D_FF), D_MODEL ** -0.5)
    ffn_w3 = nrm((N_DENSE, D_MODEL, D_FF), D_MODEL ** -0.5)
    ffn_w2 = nrm((N_DENSE, D_FF, D_MODEL), D_FF ** -0.5 * DN_BETA)
    router_w = nrm((N_MOE, D_MODEL, N_EXPERTS), D_MODEL ** -0.5)
    moe_w1 = nrm((N_MOE, N_EXPERTS, D_MODEL, D_FF), D_MODEL ** -0.5)
    moe_w3 = nrm((N_MOE, N_EXPERTS, D_MODEL, D_FF), D_MODEL ** -0.5)
    moe_w2 = nrm((N_MOE, N_EXPERTS, D_FF, D_MODEL), D_FF ** -0.5 * DN_BETA)
    ln3_g = 1.0 + nrm((DEPTH, D_MODEL), 0.02)
    ln3_b = nrm((DEPTH, D_MODEL), 0.02)
    return {"x": x, "mem": mem, "w_in": w_in, "ssm_conv_w": ssm_conv_w, "ssm_conv_b": ssm_conv_b,
            "ssm_dt_bias": ssm_dt_bias, "ssm_a_log": ssm_a_log, "ssm_d": ssm_d, "ssm_norm_w": ssm_norm_w,
            "fox_f_bias": fox_f_bias, "pool_w": pool_w, "pool_b": pool_b, "pool_scale": pool_scale,
            "w_out": w_out, "ln1_g": ln1_g, "ln1_b": ln1_b, "xa_wq": xa_wq, "xa_wk": xa_wk,
            "xa_wv": xa_wv, "xa_wo": xa_wo, "ln2_g": ln2_g, "ln2_b": ln2_b, "ffn_w1": ffn_w1,
            "ffn_w3": ffn_w3, "ffn_w2": ffn_w2, "router_w": router_w, "moe_w1": moe_w1,
            "moe_w3": moe_w3, "moe_w2": moe_w2, "ln3_g": ln3_g, "ln3_b": ln3_b}


def reference(x, mem, w_in, ssm_conv_w, ssm_conv_b, ssm_dt_bias, ssm_a_log, ssm_d, ssm_norm_w,
              fox_f_bias, pool_w, pool_b, pool_scale, w_out, ln1_g, ln1_b, xa_wq, xa_wk, xa_wv,
              xa_wo, ln2_g, ln2_b, ffn_w1, ffn_w3, ffn_w2, router_w, moe_w1, moe_w3, moe_w2,
              ln3_g, ln3_b):
    for layer in range(DEPTH):
        h = x @ w_in[layer]
        z, xbc, dt_raw, q, k, v, f_logit, pool_in = split_in(h)
        y_ssd = ssd_mixer(z, xbc, dt_raw, ssm_conv_w[layer], ssm_conv_b[layer], ssm_dt_bias[layer],
                          ssm_a_log[layer], ssm_d[layer], ssm_norm_w[layer])
        y_fox = fox_mixer(q, k, v, f_logit, fox_f_bias[layer])
        y_pool = pool_mixer(pool_in, pool_w[layer], pool_b[layer], pool_scale[layer])
        mix = jnp.concatenate([y_ssd, y_fox, y_pool], axis=-1) @ w_out[layer]
        x = layer_norm(DN_ALPHA * x + mix, ln1_g[layer], ln1_b[layer])
        xa = cross_attention(x, mem, xa_wq[layer], xa_wk[layer], xa_wv[layer], xa_wo[layer])
        x = layer_norm(DN_ALPHA * x + xa, ln2_g[layer], ln2_b[layer])
        j = layer // 2
        if layer % 2 == 0:
            ff = swiglu(x, ffn_w1[j], ffn_w3[j], ffn_w2[j])
        else:
            ff = moe_swiglu(x, router_w[j], moe_w1[j], moe_w3[j], moe_w2[j])
        x = layer_norm(DN_ALPHA * x + ff, ln3_g[layer], ln3_b[layer])
    return x
```

```cpp
#include <hip/hip_runtime.h>
#include <cstdio>
#include <cstdint>
__device__ __forceinline__ int lane_id_fresh() { int l; asm volatile("v_mbcnt_lo_u32_b32 %0, -1, 0\n\tv_mbcnt_hi_u32_b32 %0, -1, %0" : "=v"(l)); return l; }
namespace pg8 {
#define PG8_LAS __attribute__((address_space(3)))
typedef unsigned short bf16_t;
typedef short bf16x8 __attribute__((ext_vector_type(8)));
typedef float f32x4 __attribute__((ext_vector_type(4)));
typedef unsigned u32x4 __attribute__((ext_vector_type(4)));
constexpr int BM = 256, BK = 64, HALF = 128, HTB = HALF * BK * 2  , STAGE_BYTES = 8 * HTB, NXCD = 8, WGM = 8;

__host__ __device__ __forceinline__ int lds_byte(int r, int c) { const int st = (r >> 4) * 2 + (c >> 5), rr = r & 15, cc = c & 31, ob = rr * 64 + cc * 2; return st * 1024 + (ob ^ (((ob >> 9) & 1) << 5)); }
__host__ __device__ __forceinline__ void stage_rc(int b, int& R, int& C) { const int st = b / 1024, sb = b % 1024, swz = sb ^ (((sb >> 9) & 1) << 5); R = (st >> 1) * 16 + swz / 64; C = (st & 1) * 32 + (swz % 64) / 2; }
__host__ __device__ __forceinline__ int perm32(int rho) { const int n = rho >> 4, i = rho & 15; return 8 * (i >> 2) + 4 * n + (i & 3); }

struct Unit { int pm, pn; };

struct StaticOrder {
    int nM, nN, nwg, G, c;
    __host__ __device__ void init(int M, int N, int G_, int c_) { nM = M / BM; nN = N / BM; nwg = nM * nN; G = G_; c = c_; }
    __host__ __device__ bool next(int i, Unit& u) const {
        const long L = (long)i * G + c; if (L >= nwg) return false;
        int wgid = (int)L; { const int q = nwg / NXCD, r = nwg % NXCD, xcd = wgid % NXCD, off = wgid / NXCD; wgid = (xcd < r ? xcd * (q + 1) : r * (q + 1) + (xcd - r) * q) + off; }
        const int nig = WGM * nN, gid = wgid / nig, fm = gid * WGM, gsz = (nM - fm) < WGM ? (nM - fm) : WGM;
        u.pm = fm + ((wgid % nig) % gsz); u.pn = (wgid % nig) / gsz; return true;
    }
    __device__ __forceinline__ void a_ready(const Unit&) const {}
    __device__ __forceinline__ void done(const Unit&) const {}
};

__device__ __forceinline__ unsigned cvt_pk_bf16(float lo, float hi) { unsigned r; asm volatile("v_cvt_pk_bf16_f32 %0, %1, %2" : "=v"(r) : "v"(lo), "v"(hi)); return r; }
typedef float f32x2 __attribute__((ext_vector_type(2)));
__device__ __forceinline__ f32x2 gelu_pk(f32x2 v) {
    const f32x2 av = __builtin_elementwise_abs(v), d = av * 0.2316418882f + 1.0f;
    f32x2 t; t.x = __builtin_amdgcn_rcpf(d.x); t.y = __builtin_amdgcn_rcpf(d.y);
    f32x2 q = t * 0.5307027145f + (-0.7265760135f); q = q * t + 0.7107068705f; q = q * t + (-0.142248368f); q = q * t + 0.127414796f; q = q * t;
    const f32x2 s = (v * v) * (-0.72134752044f);
    f32x2 e; e.x = __builtin_amdgcn_exp2f(s.x); e.y = __builtin_amdgcn_exp2f(s.y);
    const f32x2 m = v * (q * e), r = v - m;
    f32x2 o; o.x = v.x < 0.f ? m.x : r.x; o.y = v.y < 0.f ? m.y : r.y; return o;
}

template <int ACT  > struct EpiBf16 {
    static constexpr bool PERM = true, AFTER_DRAIN = false; static_assert(ACT == 0 || ACT == 1, "EpiBf16: ACT is 0 (none) or 1 (gelu_pk)");
    bf16_t* O; int ldc; const float* bias; int split_cols; size_t split_stride; float scale0;
    __device__ __forceinline__ void operator()(const f32x4 (&acc)[2][2][4][2], const Unit& u, int wr, int wc, int fr, int fq) const {
        const int row0 = u.pm * BM + wr * 64 + fr; int colt = u.pn * BM; bf16_t* base = O;
        float sc = 1.f; if (split_cols) { const int t = colt / split_cols; base += (size_t)t * split_stride; colt -= t * split_cols; if (t == 0) sc = scale0; }
        const int col0 = colt + wc * 32 + 8 * fq, bcol0 = u.pn * BM + wc * 32 + 8 * fq;
        f32x4 bv[2][2];
#pragma unroll
        for (int bj = 0; bj < 2; ++bj)
#pragma unroll
            for (int n = 0; n < 2; ++n) bv[bj][n] = bias ? *(const f32x4*)(bias + bcol0 + bj * HALF + 4 * n) : (f32x4){0.f, 0.f, 0.f, 0.f};
#pragma unroll
        for (int ai = 0; ai < 2; ++ai)
#pragma unroll
            for (int m = 0; m < 4; ++m) { bf16_t* rowp = base + (size_t)(row0 + ai * HALF + m * 16) * ldc + col0;
#pragma unroll
                for (int bj = 0; bj < 2; ++bj) { f32x4 v0 = acc[ai][bj][m][0] + bv[bj][0], v1 = acc[ai][bj][m][1] + bv[bj][1];
                    if (ACT == 1) { f32x2 a = gelu_pk((f32x2){v0[0], v0[1]}), b = gelu_pk((f32x2){v0[2], v0[3]}), c = gelu_pk((f32x2){v1[0], v1[1]}), d = gelu_pk((f32x2){v1[2], v1[3]});
                        v0 = (f32x4){a.x, a.y, b.x, b.y}; v1 = (f32x4){c.x, c.y, d.x, d.y}; }
                    v0 = v0 * sc; v1 = v1 * sc; u32x4 w; w.x = cvt_pk_bf16(v0[0], v0[1]); w.y = cvt_pk_bf16(v0[2], v0[3]); w.z = cvt_pk_bf16(v1[0], v1[1]); w.w = cvt_pk_bf16(v1[2], v1[3]);
                    *(u32x4*)(rowp + bj * HALF) = w; } }
    }
};

struct PanelStats {
    unsigned* xbuf;
    unsigned* cnt;
    unsigned* tmo;
    int ntn; float eps;
    unsigned code;
    __device__ __forceinline__ bool run(const f32x4 (&v)[2][2][4][2], const Unit& u, int wr, int wc, int fr, int fq, PG8_LAS unsigned char* lds, int wid, int lane) const {
        typedef float f32x2v __attribute__((ext_vector_type(2)));
        PG8_LAS f32x2v* P = (PG8_LAS f32x2v*)lds;
        PG8_LAS f32x2v* S = (PG8_LAS f32x2v*)(lds + 8192);
        PG8_LAS unsigned* flag = (PG8_LAS unsigned*)(lds + 8192 + 2048);
#pragma unroll
        for (int ai = 0; ai < 2; ++ai)
#pragma unroll
            for (int m = 0; m < 4; ++m) {
                float s = 0.f;
#pragma unroll
                for (int bj = 0; bj < 2; ++bj)
#pragma unroll
                    for (int n = 0; n < 2; ++n) { const f32x4 x = v[ai][bj][m][n]; s += (x[0] + x[1]) + (x[2] + x[3]); }
                s += __shfl_xor(s, 16); s += __shfl_xor(s, 32);
                const float mw = s * (1.0f / 64.0f); float q = 0.f;
#pragma unroll
                for (int bj = 0; bj < 2; ++bj)
#pragma unroll
                    for (int n = 0; n < 2; ++n) { const f32x4 d = v[ai][bj][m][n] - mw; q += (d[0] * d[0] + d[1] * d[1]) + (d[2] * d[2] + d[3] * d[3]); }
                q += __shfl_xor(q, 16); q += __shfl_xor(q, 32);
                if (fq == 0) P[(ai * HALF + wr * 64 + m * 16 + fr) * 4 + wc] = (f32x2v){mw, q};
            }
        asm volatile("s_waitcnt lgkmcnt(0)" ::: "memory"); __builtin_amdgcn_s_barrier(); asm volatile("" ::: "memory");
#if defined(BROKEN_EXCHANGE_NO_WAIT)
#warning BROKEN CONTROL BUILD: the row-statistics exchange does not wait; results are wrong by design
        if (blockIdx.x >= 64) { const long long t0_ = clock64(); while (clock64() - t0_ < 60000) __builtin_amdgcn_s_sleep(8); }
#endif
        const int row = wid * 32 + (lane & 31);
        if (lane < 32) {
            const f32x2v a = P[row * 4 + 0], b = P[row * 4 + 1], c = P[row * 4 + 2], d = P[row * 4 + 3];
            const float mt = (a.x + b.x + c.x + d.x) * 0.25f;
            const float da = a.x - mt, db = b.x - mt, dc = c.x - mt, dd = d.x - mt;
            const float m2 = (a.y + b.y) + (c.y + d.y) + 64.0f * ((da * da + db * db) + (dc * dc + dd * dd));
            unsigned long long* slot = (unsigned long long*)xbuf + ((size_t)(u.pm * BM + row) * 4 + u.pn);
            __hip_atomic_store(slot, ((unsigned long long)__float_as_uint(m2) << 32) | __float_as_uint(mt), __ATOMIC_RELAXED, __HIP_MEMORY_SCOPE_AGENT);
        }
        asm volatile("s_waitcnt vmcnt(0)" ::: "memory");
        if (lane == 0) __hip_atomic_fetch_add(cnt + 64 * u.pm, 1u, __ATOMIC_RELAXED, __HIP_MEMORY_SCOPE_AGENT);
        if (wid == 0) {
            bool dead = false; const unsigned long long t0 = __builtin_amdgcn_s_memrealtime(); const unsigned want = 8u * (unsigned)ntn;
            for (;;) {
#if defined(BROKEN_EXCHANGE_NO_WAIT)
                break;
#endif
                if ((unsigned)__builtin_amdgcn_readfirstlane(__hip_atomic_load(cnt + 64 * u.pm, __ATOMIC_RELAXED, __HIP_MEMORY_SCOPE_AGENT)) >= want) break;
                if (__builtin_amdgcn_s_memrealtime() - t0 > 2000000ull) {
                    if (lane == 0) { unsigned expect = 0u; __hip_atomic_compare_exchange_strong(tmo + 1, &expect, code | (unsigned)(u.pm & 0xff), __ATOMIC_RELAXED, __ATOMIC_RELAXED, __HIP_MEMORY_SCOPE_AGENT);
                                     __hip_atomic_store(tmo, 1u, __ATOMIC_RELAXED, __HIP_MEMORY_SCOPE_AGENT); }
                    dead = true; break; }
                __builtin_amdgcn_s_sleep(2);
            }
            __builtin_amdgcn_fence(__ATOMIC_ACQUIRE, "agent");
            if (lane == 0) flag[0] = dead ? 1u : 0u;
        }
        asm volatile("s_waitcnt vmcnt(0) lgkmcnt(0)" ::: "memory"); __builtin_amdgcn_s_barrier(); asm volatile("" ::: "memory");
        const bool bad = flag[0] != 0u;
        if (lane < 32) {
            const unsigned long long* slot = (const unsigned long long*)xbuf + (size_t)(u.pm * BM + row) * 4; float mt[4], m2[4]; float ms = 0.f;
#pragma unroll
            for (int t = 0; t < 4; ++t) { if (t < ntn) { const unsigned long long w = __hip_atomic_load(slot + t, __ATOMIC_RELAXED, __HIP_MEMORY_SCOPE_AGENT); mt[t] = __uint_as_float((unsigned)w); m2[t] = __uint_as_float((unsigned)(w >> 32)); } else { mt[t] = 0.f; m2[t] = 0.f; } ms += mt[t]; }
            const float mean = ms / (float)ntn; float q = 0.f;
#pragma unroll
            for (int t = 0; t < 4; ++t) if (t < ntn) { const float dm = mt[t] - mean; q += m2[t] + 256.0f * dm * dm; }
            S[row] = (f32x2v){mean, 1.0f / sqrtf(q / (256.0f * (float)ntn) + eps)};
        }
        asm volatile("s_waitcnt lgkmcnt(0)" ::: "memory"); __builtin_amdgcn_s_barrier(); asm volatile("" ::: "memory");
        return bad;
    }
};
struct EpiLnRes {
    static constexpr bool PERM = false, AFTER_DRAIN = true;
    const float* base; float* out; int ldc; const float* bias; PanelStats st; unsigned poison;
    __device__ __forceinline__ void fused(f32x4 (&acc)[2][2][4][2], const Unit& u, int wr, int wc, int fr, int fq, PG8_LAS unsigned char* lds, int wid, int lane) const {
        typedef float f32x2v __attribute__((ext_vector_type(2)));
        const PG8_LAS f32x2v* S = (const PG8_LAS f32x2v*)(lds + 8192);
        const int col0 = u.pn * BM + wc * 32 + 4 * fq;
#pragma unroll
        for (int bj = 0; bj < 2; ++bj)
#pragma unroll
            for (int n = 0; n < 2; ++n) { const f32x4 bv = bias ? *(const f32x4*)(bias + col0 + bj * HALF + n * 16) : (f32x4){0.f, 0.f, 0.f, 0.f};
#pragma unroll
                for (int ai = 0; ai < 2; ++ai)
#pragma unroll
                    for (int m = 0; m < 4; ++m) acc[ai][bj][m][n] += bv; }
        f32x4 pre[4][2][2];
#pragma unroll
        for (int m = 0; m < 4; ++m) { const size_t off = (size_t)(u.pm * BM + wr * 64 + m * 16 + fr) * ldc + col0;
#pragma unroll
            for (int bj = 0; bj < 2; ++bj)
#pragma unroll
                for (int n = 0; n < 2; ++n) pre[m][bj][n] = *(const f32x4*)(base + off + bj * HALF + n * 16); }
        const bool bad = st.run(acc, u, wr, wc, fr, fq, lds, wid, lane) || poison != 0u;
        const float qnan = __builtin_nanf("");
#pragma unroll
        for (int ai = 0; ai < 2; ++ai)
#pragma unroll
            for (int m = 0; m < 4; ++m) { const int r = ai * HALF + wr * 64 + m * 16 + fr; const f32x2v sr = S[r]; const size_t off = (size_t)(u.pm * BM + r) * ldc + col0;
#pragma unroll
                for (int bj = 0; bj < 2; ++bj)
#pragma unroll
                    for (int n = 0; n < 2; ++n) { const f32x4 bs = ai == 0 ? pre[m][bj][n] : *(const f32x4*)(base + off + bj * HALF + n * 16); f32x4 o = bs + (acc[ai][bj][m][n] - sr.x) * sr.y;
                        if (bad) o = (f32x4){qnan, qnan, qnan, qnan}; *(f32x4*)(out + off + bj * HALF + n * 16) = o; }
                if (m & 1) asm volatile("" ::: "memory"); }
    }
};
struct EpiLnResLn {
    static constexpr bool PERM = false, AFTER_DRAIN = true;
    const float* base; float* out; bf16_t* xn; int ldc; const float* bias; PanelStats st1, st2; unsigned poison;
    __device__ __forceinline__ void fused(f32x4 (&acc)[2][2][4][2], const Unit& u, int wr, int wc, int fr, int fq, PG8_LAS unsigned char* lds, int wid, int lane) const {
        typedef float f32x2v __attribute__((ext_vector_type(2))); typedef unsigned u32x2v __attribute__((ext_vector_type(2)));
        const PG8_LAS f32x2v* S = (const PG8_LAS f32x2v*)(lds + 8192);
        const int col0 = u.pn * BM + wc * 32 + 4 * fq;
#pragma unroll
        for (int bj = 0; bj < 2; ++bj)
#pragma unroll
            for (int n = 0; n < 2; ++n) { const f32x4 bv = bias ? *(const f32x4*)(bias + col0 + bj * HALF + n * 16) : (f32x4){0.f, 0.f, 0.f, 0.f};
#pragma unroll
                for (int ai = 0; ai < 2; ++ai)
#pragma unroll
                    for (int m = 0; m < 4; ++m) acc[ai][bj][m][n] += bv; }
        bool bad = st1.run(acc, u, wr, wc, fr, fq, lds, wid, lane) || poison != 0u;
        const float qnan = __builtin_nanf("");
#pragma unroll
        for (int ai = 0; ai < 2; ++ai)
#pragma unroll
            for (int m = 0; m < 4; ++m) { const int r = ai * HALF + wr * 64 + m * 16 + fr; const f32x2v sr = S[r]; const size_t off = (size_t)(u.pm * BM + r) * ldc + col0;
#pragma unroll
                for (int bj = 0; bj < 2; ++bj)
#pragma unroll
                    for (int n = 0; n < 2; ++n) { const f32x4 bs = *(const f32x4*)(base + off + bj * HALF + n * 16); acc[ai][bj][m][n] = bs + (acc[ai][bj][m][n] - sr.x) * sr.y; }
                asm volatile("" : "+v"(acc[ai][0][m][0]), "+v"(acc[ai][0][m][1]), "+v"(acc[ai][1][m][0]), "+v"(acc[ai][1][m][1]));
                if (m & 1) asm volatile("" ::: "memory"); }
        const bool bad1 = bad;
        bad = st2.run(acc, u, wr, wc, fr, fq, lds, wid, lane) || bad;
#pragma unroll
        for (int ai = 0; ai < 2; ++ai)
#pragma unroll
            for (int m = 0; m < 4; ++m) { const int r = ai * HALF + wr * 64 + m * 16 + fr; const f32x2v sr = S[r]; const size_t off = (size_t)(u.pm * BM + r) * ldc + col0;
#pragma unroll
                for (int bj = 0; bj < 2; ++bj)
#pragma unroll
                    for (int n = 0; n < 2; ++n) { const f32x4 x1 = acc[ai][bj][m][n]; *(f32x4*)(out + off + bj * HALF + n * 16) = bad1 ? (f32x4){qnan, qnan, qnan, qnan} : x1;
                        const f32x4 o = (x1 - sr.x) * sr.y; u32x2v w; w.x = cvt_pk_bf16(o[0], o[1]); w.y = cvt_pk_bf16(o[2], o[3]);
                        if (bad) { w.x = 0x7fc07fc0u; w.y = 0x7fc07fc0u; } *(u32x2v*)(xn + off + bj * HALF + n * 16) = w; }
                asm volatile("" ::: "memory"); }
    }
};

template <class Epi, class Sched, bool ALIGN_EPI = false, bool SP2 = false>
__device__ __forceinline__ void gemm_phase(PG8_LAS unsigned char* lds, const int wave_id, const int K_, const int lda, const int ldb, const Sched& S, const Epi& E) {
    const int tid_ = wave_id * 64 + lane_id_fresh();
    int K = K_; asm volatile("" : "+s"(K));
    const int tid = tid_, wid = __builtin_amdgcn_readfirstlane(tid >> 6), lane = tid & 63, wr = wid >> 2, wc = wid & 3, fr = lane & 15, fq = lane >> 4;
    const int nt = K / BK;
    unsigned voffA[2], voffB[2];
#pragma unroll
    for (int i = 0; i < 2; ++i) { int R, C; stage_rc(tid * 16 + i * 8192, R, C); const int Rb = Epi::PERM ? ((R & ~31) + perm32(R & 31)) : R;
        voffA[i] = (unsigned)(R * lda + C) * 2u; voffB[i] = (unsigned)(Rb * ldb + C) * 2u; }
    const size_t kstep = (size_t)(BK * 2);
    const size_t hstepA = (size_t)HALF * lda * 2, hstepB = (size_t)HALF * ldb * 2;
    const unsigned ldsw = (unsigned)wid * 1024u;
    const int aoff = lds_byte(wr * 64 + fr, fq * 8), boff = lds_byte(wc * 32 + fr, fq * 8);
#define PG8_SA(b, h) (((b) * 2 + (h)) * HTB)
#define PG8_SB(b, h) ((4 + (b) * 2 + (h)) * HTB)
#define PG8_STAGE(bufoff, gbase, voff) do { _Pragma("unroll") for (int _i = 0; _i < 2; ++_i) \
        __builtin_amdgcn_global_load_lds((const unsigned*)((const char*)(gbase) + (voff)[_i]), (PG8_LAS unsigned*)(lds + (bufoff) + ldsw + _i * 8192), 16, 0, 0); } while (0)
#define PG8_LDA(dst, b, h) do { _Pragma("unroll") for (int m = 0; m < 4; ++m) _Pragma("unroll") for (int k = 0; k < 2; ++k) dst[m][k] = *(const PG8_LAS bf16x8*)(lds + PG8_SA(b, h) + aoff + m * 2048 + k * 1024); } while (0)
#define PG8_LDB(dst, b, h) do { _Pragma("unroll") for (int n = 0; n < 2; ++n) _Pragma("unroll") for (int k = 0; k < 2; ++k) dst[n][k] = *(const PG8_LAS bf16x8*)(lds + PG8_SB(b, h) + boff + n * 2048 + k * 1024); } while (0)
#define PG8_MMA(ai, bj, At, Bt) do { __builtin_amdgcn_s_setprio(1); _Pragma("unroll") for (int m = 0; m < 4; ++m) _Pragma("unroll") for (int n = 0; n < 2; ++n) _Pragma("unroll") for (int k = 0; k < 2; ++k) \
        acc[ai][bj][m][n] = __builtin_amdgcn_mfma_f32_16x16x32_bf16(Bt[n][k], At[m][k], acc[ai][bj][m][n], 0, 0, 0); __builtin_amdgcn_s_setprio(0); } while (0)
#define PG8_WAIT_V(n) asm volatile("s_waitcnt vmcnt(" #n ")" ::: "memory")
#define PG8_WAIT_L(n) asm volatile("s_waitcnt lgkmcnt(" #n ")" ::: "memory")
#define PG8_BAR __builtin_amdgcn_s_barrier()
#define PG8_SCHED __builtin_amdgcn_sched_barrier(0)
    Unit cur, nxt; int ui = 0;
    if (!S.next(0, cur)) return;
    f32x4 acc[2][2][4][2];
#pragma unroll
    for (int a = 0; a < 2; ++a)
#pragma unroll
        for (int b = 0; b < 2; ++b)
#pragma unroll
            for (int m = 0; m < 4; ++m)
#pragma unroll
                for (int n = 0; n < 2; ++n) acc[a][b][m][n] = (f32x4){0.f, 0.f, 0.f, 0.f};
    bf16x8 At[4][2], B0[2][2], B1[2][2];
    const char* cA = S.Aptr(cur); const char* cB = S.Bptr(cur);
    S.a_ready(cur);
    if constexpr (SP2) {
        PG8_STAGE(PG8_SB(0, 0), cB, voffB); PG8_STAGE(PG8_SB(0, 1), cB + hstepB, voffB); PG8_STAGE(PG8_SA(0, 0), cA, voffA); PG8_STAGE(PG8_SA(0, 1), cA + hstepA, voffA);
        if (wr == 1) PG8_BAR;
        PG8_WAIT_V(2); PG8_BAR;
        PG8_STAGE(PG8_SB(1, 0), cB + kstep, voffB); PG8_STAGE(PG8_SA(1, 0), cA + kstep, voffA); PG8_STAGE(PG8_SB(1, 1), cB + hstepB + kstep, voffB);
        PG8_WAIT_V(6); PG8_BAR;
    } else {
        PG8_STAGE(PG8_SB(0, 0), cB, voffB); PG8_STAGE(PG8_SA(0, 0), cA, voffA); PG8_STAGE(PG8_SB(0, 1), cB + hstepB, voffB); PG8_STAGE(PG8_SA(0, 1), cA + hstepA, voffA);
        if (wr == 1) PG8_BAR;
        PG8_WAIT_V(4); PG8_BAR;
        PG8_STAGE(PG8_SB(1, 0), cB + kstep, voffB); PG8_STAGE(PG8_SA(1, 0), cA + kstep, voffA); PG8_STAGE(PG8_SB(1, 1), cB + hstepB + kstep, voffB);
        PG8_WAIT_V(6); PG8_BAR;
    }
    for (;;) {
        const bool has_next = S.next(ui + 1, nxt);
        const char* nA = has_next ? S.Aptr(nxt) : cA; const char* nB = has_next ? S.Bptr(nxt) : cB;
        for (int t = 0; t < nt; t += 2) {
            const bool last = (t == nt - 2);
            const char* a1 = cA + (size_t)(t + 1) * kstep;
            const char* a2 = last ? nA : cA + (size_t)(t + 2) * kstep; const char* b2 = last ? nB : cB + (size_t)(t + 2) * kstep;
            const char* a3 = a2 + kstep; const char* b3 = b2 + kstep;
            if (last && has_next) S.a_ready(nxt);
            if constexpr (SP2) {
            PG8_LDB(B0, 0, 0); PG8_LDB(B1, 0, 1); PG8_SCHED; PG8_LDA(At, 0, 0); PG8_STAGE(PG8_SA(1, 1), a1 + hstepA, voffA);
            PG8_WAIT_V(8); PG8_WAIT_L(0); PG8_BAR; PG8_MMA(0, 0, At, B0); PG8_MMA(0, 1, At, B1); PG8_BAR; PG8_SCHED;
            PG8_LDA(At, 0, 1); PG8_STAGE(PG8_SB(0, 0), b2, voffB); PG8_STAGE(PG8_SB(0, 1), b2 + hstepB, voffB); PG8_STAGE(PG8_SA(0, 0), a2, voffA);
            PG8_WAIT_V(8); PG8_WAIT_L(0); PG8_BAR; PG8_MMA(1, 0, At, B0); PG8_MMA(1, 1, At, B1); PG8_BAR; PG8_SCHED;
            PG8_LDB(B0, 1, 0); PG8_LDB(B1, 1, 1); PG8_SCHED; PG8_LDA(At, 1, 0); PG8_STAGE(PG8_SA(0, 1), a2 + hstepA, voffA);
            PG8_WAIT_V(8); PG8_WAIT_L(0); PG8_BAR; PG8_MMA(0, 0, At, B0); PG8_MMA(0, 1, At, B1); PG8_BAR; PG8_SCHED;
            PG8_LDA(At, 1, 1); PG8_STAGE(PG8_SB(1, 0), b3, voffB); PG8_STAGE(PG8_SB(1, 1), b3 + hstepB, voffB); PG8_STAGE(PG8_SA(1, 0), a3, voffA);
            PG8_WAIT_V(8); PG8_WAIT_L(0); PG8_BAR; PG8_MMA(1, 0, At, B0); PG8_MMA(1, 1, At, B1); PG8_BAR; PG8_SCHED;
            } else {
            PG8_LDB(B0, 0, 0); PG8_SCHED; PG8_LDA(At, 0, 0); PG8_STAGE(PG8_SA(1, 1), a1 + hstepA, voffA);
            PG8_WAIT_L(8); PG8_BAR; PG8_WAIT_L(0); PG8_MMA(0, 0, At, B0); PG8_BAR; PG8_SCHED;
            PG8_LDB(B1, 0, 1); PG8_STAGE(PG8_SB(0, 0), b2, voffB);
            PG8_BAR; PG8_WAIT_L(0); PG8_MMA(0, 1, At, B1); PG8_BAR;
            PG8_LDA(At, 0, 1); PG8_STAGE(PG8_SA(0, 0), a2, voffA);
            PG8_BAR; PG8_WAIT_L(0); PG8_MMA(1, 0, At, B0); PG8_BAR; PG8_SCHED;
            PG8_STAGE(PG8_SB(0, 1), b2 + hstepB, voffB);
            PG8_WAIT_V(6); PG8_BAR; PG8_MMA(1, 1, At, B1); PG8_BAR;
            PG8_LDB(B0, 1, 0); PG8_SCHED; PG8_LDA(At, 1, 0); PG8_STAGE(PG8_SA(0, 1), a2 + hstepA, voffA);
            PG8_WAIT_L(8); PG8_BAR; PG8_WAIT_L(0); PG8_MMA(0, 0, At, B0); PG8_BAR; PG8_SCHED;
            PG8_LDB(B1, 1, 1); PG8_STAGE(PG8_SB(1, 0), b3, voffB);
            PG8_BAR; PG8_WAIT_L(0); PG8_MMA(0, 1, At, B1); PG8_BAR;
            PG8_LDA(At, 1, 1); PG8_STAGE(PG8_SA(1, 0), a3, voffA);
            PG8_BAR; PG8_WAIT_L(0); PG8_MMA(1, 0, At, B0); PG8_BAR; PG8_SCHED;
            PG8_STAGE(PG8_SB(1, 1), b3 + hstepB, voffB);
            PG8_WAIT_V(6); PG8_BAR; PG8_MMA(1, 1, At, B1); PG8_BAR;
            }
        }
        if constexpr (ALIGN_EPI) { if (wr == 0) PG8_BAR; }
        if constexpr (!Epi::AFTER_DRAIN) { const int l2 = lane_id_fresh(); E(acc, cur, wr, wc, l2 & 15, l2 >> 4); S.done(cur); }
        if (!has_next) break;
#pragma unroll
        for (int a = 0; a < 2; ++a)
#pragma unroll
            for (int b = 0; b < 2; ++b)
#pragma unroll
                for (int m = 0; m < 4; ++m)
#pragma unroll
                    for (int n = 0; n < 2; ++n) acc[a][b][m][n] = (f32x4){0.f, 0.f, 0.f, 0.f};
        cur = nxt; cA = nA; cB = nB; ++ui;
        if constexpr (ALIGN_EPI) { if (wr == 1) PG8_BAR; }
    }
    PG8_WAIT_V(0);
    if constexpr (!ALIGN_EPI) { if (wr == 0) PG8_BAR; }
    PG8_BAR;
    if constexpr (Epi::AFTER_DRAIN) { E.fused(acc, cur, wr, wc, fr, fq, lds, wid, lane); S.done(cur); }
#undef PG8_SA
#undef PG8_SB
#undef PG8_STAGE
#undef PG8_LDA
#undef PG8_LDB
#undef PG8_MMA
#undef PG8_WAIT_V
#undef PG8_WAIT_L
#undef PG8_BAR
#undef PG8_SCHED
}
}
namespace pg8 {
struct SchedStd {
    int nM, nN, nwg, G, c; const char* A; const char* B; size_t tA, tB;
    __device__ __forceinline__ void init(int nM_, int nN_, int G_, int c_, const void* A_, int lda, const void* B_, int ldb) { nM = nM_; nN = nN_; nwg = nM * nN; G = G_; c = c_; A = (const char*)A_; B = (const char*)B_; tA = (size_t)BM * lda * 2; tB = (size_t)BM * ldb * 2; }
    __device__ __forceinline__ bool next(int i, Unit& u) const {
        const long L = (long)i * G + c; if (L >= nwg) return false;
        int wgid = (int)L; { const int q = nwg / NXCD, r = nwg % NXCD, xcd = wgid % NXCD, off = wgid / NXCD; wgid = (xcd < r ? xcd * (q + 1) : r * (q + 1) + (xcd - r) * q) + off; }
        const int nig = WGM * nN, gid = wgid / nig, fm = gid * WGM, gsz = (nM - fm) < WGM ? (nM - fm) : WGM;
        u.pm = fm + ((wgid % nig) % gsz); u.pn = (wgid % nig) / gsz; return true;
    }
    __device__ __forceinline__ const char* Aptr(const Unit& u) const { return A + (size_t)u.pm * tA; }
    __device__ __forceinline__ const char* Bptr(const Unit& u) const { return B + (size_t)u.pn * tB; }
    __device__ __forceinline__ void a_ready(const Unit&) const {}
    __device__ __forceinline__ void done(const Unit&) const {}
};
struct SchedXA {
    int G, c; const char* A; const char* B; size_t tA, sBb, sBh;
    __device__ __forceinline__ bool next(int i, Unit& u) const { const int idx = i * G + c; if (idx >= 512) return false; u.pm = ((idx >> 8) << 6) | (idx & 63); u.pn = (idx >> 6) & 3; return true; }
    __device__ __forceinline__ const char* Aptr(const Unit& u) const { return A + (size_t)u.pm * tA + (size_t)u.pn * 512; }
    __device__ __forceinline__ const char* Bptr(const Unit& u) const { return B + (size_t)(u.pm >> 6) * sBb + (size_t)u.pn * sBh; }
    __device__ __forceinline__ void a_ready(const Unit&) const {}
    __device__ __forceinline__ void done(const Unit&) const {}
};
struct SchedMoE {
    int nM, nN, nwg, G, c, lo, a_sub; int pend[8]; const char* A; const char* B; size_t tA, tB, sE;
    __device__ __forceinline__ bool next(int i, Unit& u) const {
        const long L = (long)i * G + c; if (L >= nwg) return false;
        int wgid = (int)L; { const int q = nwg / NXCD, r = nwg % NXCD, xcd = wgid % NXCD, off = wgid / NXCD; wgid = (xcd < r ? xcd * (q + 1) : r * (q + 1) + (xcd - r) * q) + off; }
        const int nig = WGM * nN, gid = wgid / nig, fm = gid * WGM, gsz = (nM - fm) < WGM ? (nM - fm) : WGM;
        u.pm = lo + fm + ((wgid % nig) % gsz); u.pn = (wgid % nig) / gsz; return true;
    }
    __device__ __forceinline__ int expert(int rb) const { int e = 0;
#pragma unroll
        for (int k = 0; k < 7; ++k) e += (rb >= pend[k]) ? 1 : 0;
        return e; }
    __device__ __forceinline__ const char* Aptr(const Unit& u) const { return A + (size_t)(u.pm - a_sub) * tA; }
    __device__ __forceinline__ const char* Bptr(const Unit& u) const { return B + (size_t)expert(u.pm) * sE + (size_t)u.pn * tB; }
    __device__ __forceinline__ void a_ready(const Unit&) const {}
    __device__ __forceinline__ void done(const Unit&) const {}
};

struct EpiBf16S {
    static constexpr bool PERM = true, AFTER_DRAIN = false;
    bf16_t* O; int ldc; int scale_tile; float scale; int pm_sub;
    __device__ __forceinline__ void operator()(const f32x4 (&acc)[2][2][4][2], const Unit& u, int wr, int wc, int fr, int fq) const {
        const int row0 = (u.pm - pm_sub) * BM + wr * 64 + fr; const int col0 = u.pn * BM + wc * 32 + 8 * fq;
        const float sc = (scale_tile < 0 || scale_tile == u.pn) ? scale : 1.f;
#pragma unroll
        for (int ai = 0; ai < 2; ++ai)
#pragma unroll
            for (int m = 0; m < 4; ++m) { bf16_t* rowp = O + (size_t)(row0 + ai * HALF + m * 16) * ldc + col0;
#pragma unroll
                for (int bj = 0; bj < 2; ++bj) { const f32x4 v0 = acc[ai][bj][m][0] * sc, v1 = acc[ai][bj][m][1] * sc;
                    u32x4 w; w.x = cvt_pk_bf16(v0[0], v0[1]); w.y = cvt_pk_bf16(v0[2], v0[3]); w.z = cvt_pk_bf16(v1[0], v1[1]); w.w = cvt_pk_bf16(v1[2], v1[3]);
                    *(u32x4*)(rowp + bj * HALF) = w; } }
    }
};
struct EpiSwiglu {
    static constexpr bool PERM = true, AFTER_DRAIN = false;
    bf16_t* O; int ldc; int pm_sub;
    __device__ __forceinline__ void operator()(const f32x4 (&acc)[2][2][4][2], const Unit& u, int wr, int wc, int fr, int fq) const {
        const int row0 = (u.pm - pm_sub) * BM + wr * 64 + fr; const int col0 = u.pn * HALF + wc * 32 + 8 * fq;
#pragma unroll
        for (int ai = 0; ai < 2; ++ai)
#pragma unroll
            for (int m = 0; m < 4; ++m) { bf16_t* rowp = O + (size_t)(row0 + ai * HALF + m * 16) * ldc + col0; float h[8];
#pragma unroll
                for (int n = 0; n < 2; ++n)
#pragma unroll
                    for (int i = 0; i < 4; ++i) { const float a = acc[ai][0][m][n][i], b = acc[ai][1][m][n][i];
                        h[4 * n + i] = a * __builtin_amdgcn_rcpf(1.f + __builtin_amdgcn_exp2f(-1.4426950408889634f * a)) * b; }
                u32x4 w; w.x = cvt_pk_bf16(h[0], h[1]); w.y = cvt_pk_bf16(h[2], h[3]); w.z = cvt_pk_bf16(h[4], h[5]); w.w = cvt_pk_bf16(h[6], h[7]);
                *(u32x4*)rowp = w; }
    }
};
struct EpiResid {
    static constexpr bool PERM = false, AFTER_DRAIN = false;
    const float* base; float* out; int ldc; float alpha;
    __device__ __forceinline__ void operator()(const f32x4 (&acc)[2][2][4][2], const Unit& u, int wr, int wc, int fr, int fq) const {
        const int row0 = u.pm * BM + wr * 64 + fr; const int col0 = u.pn * BM + wc * 32 + 4 * fq;
#pragma unroll
        for (int ai = 0; ai < 2; ++ai)
#pragma unroll
            for (int m = 0; m < 4; ++m) { const size_t off = (size_t)(row0 + ai * HALF + m * 16) * ldc + col0;
#pragma unroll
                for (int bj = 0; bj < 2; ++bj)
#pragma unroll
                    for (int n = 0; n < 2; ++n) { f32x4 o = acc[ai][bj][m][n];
                        if (base) { const f32x4 bs = *(const f32x4*)(base + off + bj * HALF + n * 16); o = bs * alpha + o; }
                        *(f32x4*)(out + off + bj * HALF + n * 16) = o; } }
    }
};
}
#include <hip/hip_bf16.h>
#include <cmath>
#include <hip/hip_bf16.h>
#include <cmath>
namespace attn_body {
using bf16=__hip_bfloat16;
using bf16x8=__attribute__((ext_vector_type(8)))short;
using s16x4=__attribute__((ext_vector_type(4)))short;
using f32x16=__attribute__((ext_vector_type(16)))float;
using u32x4=__attribute__((ext_vector_type(4)))unsigned;
constexpr int BATCH=2,NHEAD=4,SEQ=16384,D=64,DMQ=2560,DMO=1024;
constexpr int NW=8,QBLK=32,QB=QBLK*NW,KVBLK=64,NQB=SEQ/QB;
constexpr int ATTN_UNIT_ROWS=QB;
__device__ __forceinline__ int crow(int r,int hi){return (r&3)+8*(r>>2)+4*hi;}
#define SBAR() __builtin_amdgcn_sched_barrier(0)
__device__ __forceinline__ void cmask(f32x16&p0,f32x16&p1,int jb,int qrel,int hi){
  const float NEG=-INFINITY; int kb=64*jb+4*hi;
  #pragma unroll
  for(int r=0;r<16;++r){int kv=kb+(r&3)+8*(r>>2); if(kv>qrel)p0[r]=NEG; if(kv+32>qrel)p1[r]=NEG;}
}

constexpr int NSLOT=3, SLOTB=8192;
constexpr int LDS_K=0, LDS_V=NSLOT*SLOTB, LDS_WS=2*NSLOT*SLOTB, LDS_OST=LDS_WS+NW*64*4, LDS_BYTES=LDS_OST+NW*4096, LDS_CX=LDS_BYTES, LDS_PRE=LDS_CX+SEQ*4, LDS_ALL=LDS_PRE+1024;
constexpr float C2=0.125f*1.4426950408889634f;
__device__ __forceinline__ void glds16(const void*gsrc,unsigned lds_dst){unsigned keep;
  asm volatile("s_mov_b32 %0, m0\n\ts_mov_b32 m0, %2\n\ts_nop 0\n\tglobal_load_lds_dwordx4 %1, off\n\ts_mov_b32 m0, %0":"=&s"(keep):"v"(gsrc),"s"(lds_dst):"memory");}
__device__ __forceinline__ float max3f(float a,float b,float c){float r;asm("v_max3_f32 %0, %1, %2, %3":"=v"(r):"v"(a),"v"(b),"v"(c));return r;}
__device__ __forceinline__ float max2f(float a,float b){float r;asm("v_max_f32_e32 %0, %1, %2":"=v"(r):"v"(a),"v"(b));return r;}
__device__ __forceinline__ float fadd_s(float a,float b){float r;asm("v_add_f32_e32 %0, %1, %2":"=v"(r):"v"(a),"v"(b));return r;}
__device__ __forceinline__ float fsub_s(float a,float b){float r;asm("v_sub_f32_e32 %0, %1, %2":"=v"(r):"v"(a),"v"(b));return r;}
typedef float f32x2_t __attribute__((ext_vector_type(2))); typedef __bf16 bf16x2_t __attribute__((ext_vector_type(2)));
__device__ __forceinline__ unsigned cvtpk_s(float lo,float hi){f32x2_t v={lo,hi};bf16x2_t b=__builtin_convertvector(v,bf16x2_t);return __builtin_bit_cast(unsigned,b);}
#define WAIT_BAR(N) asm volatile("s_waitcnt vmcnt(" #N ") lgkmcnt(0)\n\ts_barrier":::"memory")

__device__ __forceinline__ void qkt(f32x16&p0,f32x16&p1,const char*Kslot,const bf16x8*qr,const f32x16&negm,int r32,int hi,bf16x8 kx0,bf16x8 kx1,bf16x8 onesf){
  const char*kb=Kslot+hi*1024+r32*16;
  #pragma unroll
  for(int d0=0;d0<4;++d0){
    const bf16x8 b0=*reinterpret_cast<const bf16x8*>(kb+d0*2048);
    const bf16x8 b1=*reinterpret_cast<const bf16x8*>(kb+d0*2048+512);
    if(d0==0){p0=__builtin_amdgcn_mfma_f32_32x32x16_bf16(b0,qr[0],negm,0,0,0);p1=__builtin_amdgcn_mfma_f32_32x32x16_bf16(b1,qr[0],negm,0,0,0);}
    else{p0=__builtin_amdgcn_mfma_f32_32x32x16_bf16(b0,qr[d0],p0,0,0,0);p1=__builtin_amdgcn_mfma_f32_32x32x16_bf16(b1,qr[d0],p1,0,0,0);}}
  p0=__builtin_amdgcn_mfma_f32_32x32x16_bf16(kx0,onesf,p0,0,0,0);p1=__builtin_amdgcn_mfma_f32_32x32x16_bf16(kx1,onesf,p1,0,0,0);
}
typedef __attribute__((address_space(3))) const char* lds_cptr;
typedef short v4i16_t __attribute__((ext_vector_type(4)));
__device__ __forceinline__ void kload8(bf16x8*kf,lds_cptr kp){
  kf[0]=*(const __attribute__((address_space(3))) bf16x8*)(kp);      kf[1]=*(const __attribute__((address_space(3))) bf16x8*)(kp+512);
  kf[2]=*(const __attribute__((address_space(3))) bf16x8*)(kp+2048); kf[3]=*(const __attribute__((address_space(3))) bf16x8*)(kp+2560);
  kf[4]=*(const __attribute__((address_space(3))) bf16x8*)(kp+4096); kf[5]=*(const __attribute__((address_space(3))) bf16x8*)(kp+4608);
  kf[6]=*(const __attribute__((address_space(3))) bf16x8*)(kp+6144); kf[7]=*(const __attribute__((address_space(3))) bf16x8*)(kp+6656);
}
__device__ __forceinline__ void kload2(bf16x8*kf,lds_cptr kp,int j){ kf[2*j]=*(const __attribute__((address_space(3))) bf16x8*)(kp+j*2048); kf[2*j+1]=*(const __attribute__((address_space(3))) bf16x8*)(kp+j*2048+512); }
__device__ __forceinline__ s16x4 vtr(lds_cptr p){ return __builtin_bit_cast(s16x4,__builtin_amdgcn_ds_read_tr16_b64_v4i16((__attribute__((address_space(3))) v4i16_t*)p)); }
__device__ __forceinline__ float rowmax(const f32x16&p0,const f32x16&p1){
  float a=max3f(p0[0],p0[1],p1[0]),b=max3f(p0[2],p0[3],p1[1]);a=max3f(a,p1[2],p1[3]);
  #pragma unroll
  for(int r=4;r<16;r+=4){a=max3f(a,p0[r],p0[r+1]);b=max3f(b,p0[r+2],p0[r+3]);a=max3f(a,p1[r],p1[r+1]);b=max3f(b,p1[r+2],p1[r+3]);}
  const float m=max2f(a,b);
  auto rr=__builtin_amdgcn_permlane32_swap(__float_as_uint(m),__float_as_uint(m),false,false);
  return max2f(__uint_as_float(rr[0]),__uint_as_float(rr[1]));
}
__device__ __forceinline__ void pv(f32x16*o,int vb,bf16x8 pa0,bf16x8 pa1,bf16x8 pa2,bf16x8 pa3){
  #pragma unroll
  for(int d0=0;d0<2;++d0){s16x4 lo[4],hi[4];
    #pragma unroll
    for(int ks=0;ks<4;++ks){
      asm volatile("ds_read_b64_tr_b16 %0,%1 offset:%c2":"=&v"(lo[ks]):"v"(vb),"i"(d0*4096+ks*1024):"memory");
      asm volatile("ds_read_b64_tr_b16 %0,%1 offset:%c2":"=&v"(hi[ks]):"v"(vb),"i"(d0*4096+ks*1024+512):"memory");}
    asm volatile("s_waitcnt lgkmcnt(0)":::"memory");SBAR();
    #define PK(k) (bf16x8){lo[k][0],lo[k][1],lo[k][2],lo[k][3],hi[k][0],hi[k][1],hi[k][2],hi[k][3]}
    o[d0]=__builtin_amdgcn_mfma_f32_32x32x16_bf16(pa0,PK(0),o[d0],0,0,0);
    o[d0]=__builtin_amdgcn_mfma_f32_32x32x16_bf16(pa1,PK(1),o[d0],0,0,0);
    o[d0]=__builtin_amdgcn_mfma_f32_32x32x16_bf16(pa2,PK(2),o[d0],0,0,0);
    o[d0]=__builtin_amdgcn_mfma_f32_32x32x16_bf16(pa3,PK(3),o[d0],0,0,0);
    #undef PK
  }
}

#ifndef ATTN_STORE16
#define ATTN_STORE16(p,v) (*(u32x4*)(p)=(v))
#endif
template<int THRL> __device__ __forceinline__ void attn_unit(int wave_id,int b,int h,int qb,const bf16*Q,const bf16*__restrict__ K,const bf16*__restrict__ V,bf16*O,const float*__restrict__ cloc,char*shm){
  const int tid=wave_id*64+lane_id_fresh(),lane=tid&63,r32=lane&31,hi=lane>>5; const int wid=__builtin_amdgcn_readfirstlane(tid>>6);
  const long rowbase=(long)b*SEQ; const int q0=qb*QB;
  const bf16*Qw=Q+(rowbase+q0+wid*QBLK)*DMQ+h*D;
  const bf16*Kh=K+rowbase*DMQ+h*D,*Vh=V+rowbase*DMQ+h*D;
  const unsigned lds0=(unsigned)(uintptr_t)shm;
  float*wsf=(float*)(shm+LDS_WS)+wid*64;
  const bf16*ksrc=Kh+(long)lane*DMQ+wid*8;
  const bf16*vsrc=Vh+(long)(16*(wid&3)+(lane>>2))*DMQ+(wid>>2)*32+(lane&3)*8;
  const unsigned kdst=lds0+LDS_K+wid*1024, vdst=lds0+LDS_V+wid*1024;
  #define DMA_K(t,slot) glds16(ksrc+(long)(t)*KVBLK*DMQ,(unsigned)__builtin_amdgcn_readfirstlane(kdst+(slot)))
  #define DMA_V(t,slot) glds16(vsrc+(long)(t)*KVBLK*DMQ,(unsigned)__builtin_amdgcn_readfirstlane(vdst+(slot)))
  const int vb0=(int)(lds0+LDS_V)+((lane>>4)&1)*32+(lane&3)*8+(4*hi+((lane&15)>>2))*64;
  const char*Kbase=shm+LDS_K; bf16x8 kf[8];
  const lds_cptr shm3=(lds_cptr)shm; const lds_cptr kp0=shm3+LDS_K+hi*1024+r32*16; const lds_cptr vp0=shm3+LDS_V+((lane>>4)&1)*32+(lane&3)*8+(4*hi+((lane&15)>>2))*64;
  const int NT=(q0+QB)/KVBLK;
  typedef __attribute__((address_space(3))) unsigned* lds_uptr; typedef __attribute__((address_space(3))) const float* lds_fptr;
  const lds_uptr cxw=(lds_uptr)((lds_cptr)shm+LDS_CX); const lds_fptr cpre=(lds_fptr)((lds_cptr)shm+LDS_PRE);
  { const float cref=cloc[q0]+cpre[q0>>6];
    for(int k=tid;k<q0+QB;k+=NW*64){ const float f=(cref-(cloc[k]+cpre[k>>6]))*1.4426950408889634f; const unsigned hb=cvtpk_s(f,0.f)&0xffffu; const float fh=__uint_as_float(hb<<16); const unsigned lb=cvtpk_s(f-fh,0.f)&0xffffu; cxw[k]=hb|(lb<<16);} }
  const bf16x8 onesf=__builtin_bit_cast(bf16x8,(u32x4){hi?0u:0x3F803F80u,0u,0u,0u});
  #define KXF(idx) __builtin_bit_cast(bf16x8,(u32x4){hi?0u:cxw[(idx)],0u,0u,0u})
  DMA_K(0,0);DMA_V(0,0);DMA_K(1,SLOTB);
  bf16x8 qr[4];
  #pragma unroll
  for(int d0=0;d0<4;++d0)qr[d0]=*reinterpret_cast<const bf16x8*>(&Qw[(long)r32*DMQ+d0*16+hi*8]);
  float mhat=0.f,l_reg=0.f;f32x16 o[2];o[0]=f32x16{};o[1]=f32x16{};f32x16 negm=f32x16{};asm volatile("":"+v"(negm));
  const int qrel=wid*QBLK+r32;
  #define CMASK(P0,P1,t) do{int jb_=(t)-(NT-4); if(jb_>=0)cmask(P0,P1,jb_,qrel,hi);}while(0)
  bool resc=false;
  #define START(P0,P1) do{ const float rm=rowmax(P0,P1); resc=false; \
    { const float dl=rm; mhat=fadd_s(mhat,dl); \
      _Pragma("unroll") for(int r=0;r<16;++r){P0[r]=fsub_s(P0[r],dl);P1[r]=fsub_s(P1[r],dl);} \
      _Pragma("unroll") for(int r=0;r<16;++r)negm[r]=-mhat; asm volatile("":"+v"(negm)); } \
    _Pragma("unroll") for(int r=0;r<16;++r)P0[r]=__builtin_amdgcn_exp2f(P0[r]); }while(0)
  #define RESC() do{ if(resc){ asm volatile("s_waitcnt lgkmcnt(0)":::"memory"); \
      _Pragma("unroll") for(int d_=0;d_<2;++d_) _Pragma("unroll") for(int r=0;r<16;++r)o[d_][r]*=wsf[crow(r,hi)]; } }while(0)
  f32x16 pA0,pA1,pB0,pB1;
  int sl_prev=0,sl_cur=0,sl_next=SLOTB;
  #define ROT() do{sl_prev=sl_cur;sl_cur=sl_next;sl_next=(sl_next==(NSLOT-1)*SLOTB)?0:sl_next+SLOTB;}while(0)
  DMA_K(2,2*SLOTB);
  WAIT_BAR(3);
  qkt(pA0,pA1,Kbase,qr,negm,r32,hi,KXF(r32),KXF(32+r32),onesf);asm volatile("s_nop 15\n\ts_nop 7":"+v"(pA0),"+v"(pA1));CMASK(pA0,pA1,0);
  START(pA0,pA1);
  _Pragma("unroll") for(int r=0;r<16;++r)pA1[r]=__builtin_amdgcn_exp2f(pA1[r]);
  WAIT_BAR(0);
  DMA_K(3,0);DMA_V(1,SLOTB);
  ROT();
  kload8(kf,kp0+sl_cur);
  WAIT_BAR(2);
  s16x4 vlo[8],vhi[8]; u32x4 pw0,pw1,pw2,pw3;
  #define PKW(P,B) cvtpk_s(P[B],P[B+1])
  #define PAF(k) __builtin_bit_cast(bf16x8,pw##k)
  #define VFR(i) (bf16x8){vlo[i][0],vlo[i][1],vlo[i][2],vlo[i][3],vhi[i][0],vhi[i][1],vhi[i][2],vhi[i][3]}
  #define PIN(x) asm volatile("":"+v"(x))
  #define MX3(a,b,c) __builtin_fmaxf(__builtin_fmaxf((a),(b)),(c))
  #define GAPA(MF,A0,A1,A2,A3,W0,W1,PW) do{ MF; sacc+=A0; sacc+=A1; sacc+=A2; sacc+=A3; PIN(sacc); W0; W1; PIN(PW); SBAR(); }while(0)
  #define EX(v) __builtin_amdgcn_exp2f(v)
  #define GAPB(MF,X,B) do{ MF; X[B]=EX(X[B]); X[B+1]=EX(X[B+1]); X[B+2]=EX(X[B+2]); X[B+3]=EX(X[B+3]); PIN(X); SBAR(); }while(0)
  #define VRD(i) do{ vlo[i]=vtr(vp_+(((i)>>2)*4096+((i)&3)*1024)); vhi[i]=vtr(vp_+(((i)>>2)*4096+((i)&3)*1024+512)); }while(0)
  #define KRD(G,j) do{ if(G){ kload2(kf,kp0+sl_next,j); SBAR(); } }while(0)
  #define STEP(C0,C1,P0,P1,t,GK,GV,GL) do{ SBAR(); \
    const lds_cptr vp_=vp0+sl_prev; const bf16x8 kx0_=KXF((t)*KVBLK+r32), kx1_=KXF((t)*KVBLK+32+r32); \
    VRD(0); SBAR(); float sacc=(P0[0]+P0[1]); \
    GAPA(C0=__builtin_amdgcn_mfma_f32_32x32x16_bf16(kf[0],qr[0],negm,0,0,0), P0[2],P0[3],P0[4],P0[5],     pw0[0]=PKW(P0,0), pw0[1]=PKW(P0,2), pw0); \
    VRD(4); SBAR(); GAPA(C1=__builtin_amdgcn_mfma_f32_32x32x16_bf16(kf[1],qr[0],negm,0,0,0), P0[6],P0[7],P0[8],P0[9],     pw0[2]=PKW(P0,4), pw0[3]=PKW(P0,6), pw0); \
    VRD(1); SBAR(); GAPA(C0=__builtin_amdgcn_mfma_f32_32x32x16_bf16(kf[2],qr[1],C0,0,0,0),   P0[10],P0[11],P0[12],P0[13], pw1[0]=PKW(P0,8), pw1[1]=PKW(P0,10), pw1); \
    VRD(5); SBAR(); GAPA(C1=__builtin_amdgcn_mfma_f32_32x32x16_bf16(kf[3],qr[1],C1,0,0,0),   P0[14],P0[15],P1[0],P1[1],   pw1[2]=PKW(P0,12),pw1[3]=PKW(P0,14), pw1); \
    VRD(2); SBAR(); GAPA(C0=__builtin_amdgcn_mfma_f32_32x32x16_bf16(kf[4],qr[2],C0,0,0,0),   P1[2],P1[3],P1[4],P1[5],     pw2[0]=PKW(P1,0), pw2[1]=PKW(P1,2), pw2); \
    VRD(6); SBAR(); GAPA(C1=__builtin_amdgcn_mfma_f32_32x32x16_bf16(kf[5],qr[2],C1,0,0,0),   P1[6],P1[7],P1[8],P1[9],     pw2[2]=PKW(P1,4), pw2[3]=PKW(P1,6), pw2); \
    VRD(3); SBAR(); GAPA(C0=__builtin_amdgcn_mfma_f32_32x32x16_bf16(kf[6],qr[3],C0,0,0,0),   P1[10],P1[11],P1[12],P1[13], pw3[0]=PKW(P1,8), pw3[1]=PKW(P1,10), pw3); \
    VRD(7); SBAR(); GAPA(C1=__builtin_amdgcn_mfma_f32_32x32x16_bf16(kf[7],qr[3],C1,0,0,0),   P1[14],P1[15],0.f,0.f,       pw3[2]=PKW(P1,12),pw3[3]=PKW(P1,14), pw3); \
    C0=__builtin_amdgcn_mfma_f32_32x32x16_bf16(kx0_,onesf,C0,0,0,0); C1=__builtin_amdgcn_mfma_f32_32x32x16_bf16(kx1_,onesf,C1,0,0,0); \
    l_reg+=sacc; \
    if(GK){DMA_K((t)+3,sl_cur);} if(GV){DMA_V((t)+1,sl_next);} \
    CMASK(C0,C1,t); \
    { float a=MX3(C0[0],C0[1],C1[0]),b=MX3(C0[2],C0[3],C1[1]); a=MX3(a,C1[2],C1[3]); \
      _Pragma("unroll") for(int r=4;r<16;r+=4){a=MX3(a,C0[r],C0[r+1]);b=MX3(b,C0[r+2],C0[r+3]);a=MX3(a,C1[r],C1[r+1]);b=MX3(b,C1[r+2],C1[r+3]);} \
      float rm=__builtin_fmaxf(a,b); { auto rr=__builtin_amdgcn_permlane32_swap(__float_as_uint(rm),__float_as_uint(rm),false,false); rm=__builtin_fmaxf(__uint_as_float(rr[0]),__uint_as_float(rr[1])); } \
      resc=false; \
      if(__builtin_expect(__any(rm>(float)THRL),0)){ const float dl=__builtin_fmaxf(rm,0.f); mhat+=dl; \
        _Pragma("unroll") for(int r=0;r<16;++r){C0[r]-=dl;C1[r]-=dl;} \
        _Pragma("unroll") for(int r=0;r<16;++r)negm[r]=-mhat; asm volatile("":"+v"(negm)); \
        const float f=__builtin_amdgcn_exp2f(-dl); l_reg*=f; if(hi==0)wsf[r32]=f; resc=true; } } \
    SBAR(); \
    GAPB(o[0]=__builtin_amdgcn_mfma_f32_32x32x16_bf16(PAF(0),VFR(0),o[0],0,0,0), C0,0); \
    GAPB(o[1]=__builtin_amdgcn_mfma_f32_32x32x16_bf16(PAF(0),VFR(4),o[1],0,0,0), C0,4); \
    KRD(GL,0); GAPB(o[0]=__builtin_amdgcn_mfma_f32_32x32x16_bf16(PAF(1),VFR(1),o[0],0,0,0), C0,8); \
    KRD(GL,1); GAPB(o[1]=__builtin_amdgcn_mfma_f32_32x32x16_bf16(PAF(1),VFR(5),o[1],0,0,0), C0,12); \
    KRD(GL,2); GAPB(o[0]=__builtin_amdgcn_mfma_f32_32x32x16_bf16(PAF(2),VFR(2),o[0],0,0,0), C1,0); \
    KRD(GL,3); GAPB(o[1]=__builtin_amdgcn_mfma_f32_32x32x16_bf16(PAF(2),VFR(6),o[1],0,0,0), C1,4); \
    GAPB(o[0]=__builtin_amdgcn_mfma_f32_32x32x16_bf16(PAF(3),VFR(3),o[0],0,0,0), C1,8); \
    GAPB(o[1]=__builtin_amdgcn_mfma_f32_32x32x16_bf16(PAF(3),VFR(7),o[1],0,0,0), C1,12); \
    }while(0)
  int t=1;
  #undef CMASK
  #define CMASK(P0,P1,t) do{}while(0)
  for(;t+5<NT;t+=2){
    STEP(pB0,pB1,pA0,pA1,t,true,true,true);     WAIT_BAR(2); RESC(); ROT();
    STEP(pA0,pA1,pB0,pB1,t+1,true,true,true);   WAIT_BAR(2); RESC(); ROT();
  }
  #undef CMASK
  #define CMASK(P0,P1,t) do{int jb_=(t)-(NT-4); if(jb_>=0)cmask(P0,P1,jb_,qrel,hi);}while(0)
  #define ENDW(tt) do{ if((tt)+3<NT){WAIT_BAR(2);} else if((tt)+2<NT){WAIT_BAR(1);} else {WAIT_BAR(0);} }while(0)
  for(;t+1<NT;t+=2){
    STEP(pB0,pB1,pA0,pA1,t,(t+3<NT),(t+1<NT),(t+1<NT));       ENDW(t);   RESC(); ROT();
    STEP(pA0,pA1,pB0,pB1,t+1,(t+4<NT),(t+2<NT),(t+2<NT));     ENDW(t+1); RESC(); ROT();
  }
  STEP(pB0,pB1,pA0,pA1,NT-1,false,false,false); RESC();
  { float sacc=pB0[0]+pB0[1]; _Pragma("unroll") for(int r=2;r<16;++r)sacc+=pB0[r]; _Pragma("unroll") for(int r=0;r<16;++r)sacc+=pB1[r]; l_reg+=sacc;
    pw0=(u32x4){PKW(pB0,0),PKW(pB0,2),PKW(pB0,4),PKW(pB0,6)};pw1=(u32x4){PKW(pB0,8),PKW(pB0,10),PKW(pB0,12),PKW(pB0,14)};pw2=(u32x4){PKW(pB1,0),PKW(pB1,2),PKW(pB1,4),PKW(pB1,6)};pw3=(u32x4){PKW(pB1,8),PKW(pB1,10),PKW(pB1,12),PKW(pB1,14)};
    SBAR(); pv(o,vb0+sl_cur,PAF(0),PAF(1),PAF(2),PAF(3)); }
  #undef PKW
  #undef PAF
  #undef VFR
  #undef PIN
  #undef MX3
  #undef GAPA
  #undef GAPB
  #undef EX
  #undef VRD
  #undef KRD
  #undef STEP
  #undef ENDW
  {auto rr=__builtin_amdgcn_permlane32_swap(__float_as_uint(l_reg),__float_as_uint(l_reg),false,false);l_reg=__uint_as_float(rr[0])+__uint_as_float(rr[1]);}
  if(hi==0)wsf[32+r32]=l_reg;asm volatile("s_waitcnt lgkmcnt(0)":::"memory");
  float rli[16];
  #pragma unroll
  for(int r=0;r<16;++r)rli[r]=__builtin_amdgcn_rcpf(wsf[32+crow(r,hi)]);
  bf16*Ow=O+(rowbase+q0+wid*QBLK)*DMO+h*D;
  { bf16*stg=(bf16*)(shm+LDS_OST)+wid*2048;
    #pragma unroll
    for(int r=0;r<16;++r){const int orow=crow(r,hi);
      #pragma unroll
      for(int d0=0;d0<2;++d0)stg[orow*64+d0*32+r32]=__float2bfloat16(o[d0][r]*rli[r]);}
    asm volatile("s_waitcnt lgkmcnt(0)":::"memory");
    #pragma unroll
    for(int i=0;i<4;++i){const int row=i*8+(lane>>3),ch=lane&7; const u32x4 v=*(const u32x4*)(stg+row*64+ch*8); ATTN_STORE16(Ow+(long)row*DMO+ch*8,v);} }
  asm volatile("s_waitcnt lgkmcnt(0)\n\ts_barrier":::"memory");
  #undef DMA_K
  #undef KXF
  #undef DMA_V
  #undef CMASK
  #undef START
  #undef RESC
  #undef ROT
}
constexpr int ATTN_LDS_BYTES=LDS_BYTES;
struct AttnTensors { const bf16* Q; const bf16* K; const bf16* V; bf16* O; const float* cloc; const float* ctot; };
struct AttnUnit { int bh; int qb; };
struct StaticOrder {
  int vcu, G;
  __device__ __forceinline__ explicit StaticOrder(int grid,int block):vcu((grid%8==0)?(block%8)*(grid/8)+block/8:block),G(grid){}
  __device__ __forceinline__ bool next(int i,AttnUnit&u)const{
    if(G==256){ if(i>=2)return false; const int s=vcu&31; u.bh=vcu>>5; u.qb=(i==0)?63-s:s; return true; }
    const int idx=vcu+i*G; if(idx>=BATCH*NHEAD*NQB)return false; u.bh=idx/NQB; u.qb=NQB-1-idx%NQB; return true; }
  __device__ __forceinline__ void a_ready(const AttnUnit&)const{}
  __device__ __forceinline__ void done(const AttnUnit&)const{}
};
template<class Sched,int THRL=8> __device__ __forceinline__ void attn_phase(char*lds,int wave_id,const AttnTensors&T,const Sched&S){
  AttnUnit u;
  for(int i=0;S.next(i,u);++i){ S.a_ready(u);
    {
      const int tid=wave_id*64+lane_id_fresh(),lane=tid&63;
      if(tid<64){ const float*ct=T.ctot+(long)u.bh*(SEQ/64)+4*lane; const float t0=ct[0],t1=ct[1],t2=ct[2],t3=ct[3]; float tot=(t0+t1)+(t2+t3), inc=tot;
        #pragma unroll
        for(int o=1;o<64;o<<=1){ const float v=__int_as_float(__builtin_amdgcn_ds_bpermute(((lane-o)&63)<<2,__float_as_int(inc))); if(lane>=o)inc+=v; }
        const float ex=inc-tot; __attribute__((address_space(3))) float*pre=(__attribute__((address_space(3))) float*)((lds_cptr)lds+LDS_PRE)+4*lane;
        pre[0]=ex; pre[1]=ex+t0; pre[2]=ex+t0+t1; pre[3]=ex+t0+t1+t2; }
      asm volatile("s_waitcnt vmcnt(0) lgkmcnt(0)\n\ts_barrier":::"memory"); }
    attn_unit<THRL>(wave_id,u.bh/NHEAD,u.bh%NHEAD,u.qb,T.Q,T.K,T.V,T.O,T.cloc+(long)u.bh*SEQ,lds); S.done(u); }
}
#undef SBAR
#undef WAIT_BAR
}
#define GAS __attribute__((address_space(1)))
#define LAS __attribute__((address_space(3)))
typedef unsigned short bf16;
typedef unsigned v4u __attribute__((ext_vector_type(4)));
typedef float f32x4 __attribute__((ext_vector_type(4)));
typedef short bf16x8 __attribute__((ext_vector_type(8)));
typedef GAS unsigned gu32;
typedef GAS unsigned long long gu64;
#define RLX_AGENT __ATOMIC_RELAXED, __HIP_MEMORY_SCOPE_AGENT
#define LDS_WAIT() asm volatile("s_waitcnt lgkmcnt(0)" ::: "memory")
#define VM_WAIT() asm volatile("s_waitcnt vmcnt(0)" ::: "memory")
__device__ __forceinline__ unsigned long long rt() { return __builtin_amdgcn_s_memrealtime(); }
__device__ __forceinline__ unsigned f2bf(float f) { unsigned u = __builtin_bit_cast(unsigned, f); return (u + 0x7fffu + ((u >> 16) & 1u)) >> 16; }
__device__ __forceinline__ unsigned pk2(float lo, float hi) { return f2bf(lo) | (f2bf(hi) << 16); }

#define XB_TMO      128
#define XB_XCNT(j)  (256  + 64 * (j))
#define XB_XSUB(j)  (1280 + 64 * (j))
#define XB_XGEN(j)  (2304 + 64 * (j))
#define XB_TOP      3328
#define XB_TOPGEN   3392
#define XCD_BAR_WORDS 3456
#define XB_SPIN_CAP (1u << 18)

__device__ __forceinline__ unsigned xb_ld(unsigned* p)              { return __hip_atomic_load(p, __ATOMIC_RELAXED, __HIP_MEMORY_SCOPE_AGENT); }
__device__ __forceinline__ unsigned xb_add(unsigned* p, unsigned v) { return __hip_atomic_fetch_add(p, v, __ATOMIC_RELAXED, __HIP_MEMORY_SCOPE_AGENT); }
__device__ __forceinline__ unsigned xb_xcc_id() { return (unsigned)__builtin_amdgcn_s_getreg((3 << 11) | 20) & 0xFu; }
#define XB_SPIN(cond, bar) do { unsigned _sp = 0; while (cond) { __builtin_amdgcn_s_sleep(1); \
    if ((++_sp & 255u) == 0u) { if (xb_ld(&(bar)[XB_TMO])) break; if (_sp > XB_SPIN_CAP) { atomicAdd(&(bar)[XB_TMO], 1u); break; } } } } while (0)

struct XcdBarrier {
    unsigned* bar; unsigned x; int wave;
    volatile LAS unsigned* st;
};

__device__ __forceinline__ bool xb_thread0(int wave) { return wave == 0 && __builtin_amdgcn_mbcnt_hi(~0u, __builtin_amdgcn_mbcnt_lo(~0u, 0u)) == 0u; }
__device__ __forceinline__ XcdBarrier xcd_barrier_post(unsigned* bar, volatile LAS unsigned* st, int wave) {
    XcdBarrier b; b.bar = bar; b.x = xb_xcc_id(); b.st = st; b.wave = wave;
    if (xb_thread0(wave)) (void)xb_add(&bar[XB_XCNT(b.x)], 1u);
    return b;
}
__device__ __forceinline__ void xcd_barrier_complete(unsigned* bar, unsigned x, unsigned& nloc, unsigned& nx) {
    const unsigned G = gridDim.x * gridDim.y * gridDim.z;
    unsigned sum, cnt, mine, sp = 0u;
    for (;;) {
        sum = 0u; cnt = 0u; mine = 0u;
#pragma unroll
        for (unsigned j = 0; j < 16; ++j) { const unsigned c = xb_ld(&bar[XB_XCNT(j)]); sum += c; cnt += (c > 0u) ? 1u : 0u; mine = (j == x) ? c : mine; }
        if (sum == G) break;
        __builtin_amdgcn_s_sleep(1);
        if ((++sp & 255u) == 0u) { if (xb_ld(&bar[XB_TMO])) break; if (sp > XB_SPIN_CAP) { atomicAdd(&bar[XB_TMO], 1u); break; } }
    }
    nloc = mine > 0u ? mine : 1u; nx = cnt > 0u ? cnt : 1u;
}

__device__ __forceinline__ void xcd_barrier(const XcdBarrier& b) {
    asm volatile("s_waitcnt vmcnt(0)" ::: "memory");
    __syncthreads();
    if (xb_thread0(b.wave)) {
        unsigned* bar = b.bar;
        __builtin_amdgcn_s_waitcnt(0);
        unsigned nloc = b.st[0], nx = b.st[1];
        if (nloc == 0u) { xcd_barrier_complete(bar, b.x, nloc, nx); b.st[0] = nloc; b.st[1] = nx; }
        const unsigned old = xb_add(&bar[XB_XSUB(b.x)], 1u);
        const unsigned gen = old / nloc;
        if (old + 1u == (gen + 1u) * nloc) {
            __builtin_amdgcn_fence(__ATOMIC_RELEASE, "agent");
            asm volatile("s_waitcnt vmcnt(0)" ::: "memory");
            const unsigned og = xb_add(&bar[XB_TOP], 1u);
            const unsigned tg = og / nx;
            if (og + 1u == (tg + 1u) * nx) xb_add(&bar[XB_TOPGEN], 1u);
            else XB_SPIN(xb_ld(&bar[XB_TOPGEN]) == tg, bar);
            __builtin_amdgcn_fence(__ATOMIC_ACQUIRE, "agent");
            xb_add(&bar[XB_XGEN(b.x)], 1u);
            asm volatile("s_waitcnt vmcnt(0)" ::: "memory");
        } else {
            XB_SPIN(xb_ld(&bar[XB_XGEN(b.x)]) == gen, bar);
            __builtin_amdgcn_fence(__ATOMIC_ACQUIRE, "agent");
            asm volatile("s_waitcnt vmcnt(0)" ::: "memory");
        }
    }
    __syncthreads();
}
#define DI __device__ __forceinline__
constexpr int NB = 2, SEQ = 16384, DM = 1024, NTOK = NB * SEQ, DEPTH = 4;
constexpr int D_IN = 2572, HC = 2560;
constexpr int D_FF = 3584, NEXP = 8, MEMLEN = 256, NCH = SEQ / 64;
constexpr int HZ = 0, HXBC = 512, HQ = 1536, HK = 1792, HV = 2048, HPOOL = 2304;
constexpr float DN_ALPHA = 1.681792830507429f;
constexpr float LN_EPS = 1e-5f, RMS_EPS = 1e-5f;
constexpr int NWAVES = 8, NTHR = NWAVES * 64;
constexpr int MOE_CAP_BLK = (NTOK * 2) / 256 + NEXP;
constexpr int MOE_PASS_BLK = MOE_CAP_BLK / 3, MOE_NPASS = 3;

constexpr size_t MiB = 1u << 20, KiB = 1u << 10;
constexpr size_t WS_CTL = 0, CTL_ZERO_BYTES = 1 * MiB;
constexpr size_t WS_DTF = 1 * MiB;
constexpr size_t WS_GACS = 3 * MiB;
constexpr size_t WS_FOXC = 4 * MiB;
constexpr size_t WS_FOXT = 4 * MiB + 512 * KiB;
constexpr size_t WS_CDEC = 4 * MiB + 576 * KiB;
constexpr size_t WS_TOKE = 5 * MiB, WS_TOKG = 5 * MiB + 256 * KiB, WS_TOKS = 5 * MiB + 512 * KiB;
constexpr size_t WS_MEMB = 7 * MiB;
constexpr size_t WS_KC = 8 * MiB;
constexpr size_t WS_VT = 12 * MiB;
constexpr size_t WS_CM = 16 * MiB;
constexpr size_t WS_W = 32 * MiB;
constexpr size_t W_LAYER = 11 * MiB, W_IN = 0, W_OUT = 5 * MiB, W_Q = 7 * MiB, W_O = 9 * MiB;
constexpr size_t W_K = 44 * MiB, W_V = 52 * MiB, W_DENSE = 60 * MiB, W_FFN = 21 * MiB, W_13 = 0, W_2 = 14 * MiB, W_MOE = 102 * MiB, W_TOTAL = 438 * MiB;
constexpr size_t WS_XB = WS_W + W_TOTAL;
constexpr size_t WS_MIX = WS_XB + 64 * MiB;
constexpr size_t WS_BIG = WS_MIX + 68 * MiB;
constexpr size_t WS_Y = WS_MIX, WS_HIDM = WS_BIG + 64 * MiB;
constexpr size_t WS_ST = WS_BIG + 232 * MiB;
constexpr size_t WS_END = WS_ST + 136 * MiB;
static_assert((size_t)MOE_CAP_BLK * 256 * DM * 2 <= 132 * MiB && (size_t)MOE_PASS_BLK * 256 * D_FF * 2 <= 168 * MiB && (size_t)NTOK * HC * 2 <= 232 * MiB && (size_t)NTOK * D_FF * 2 <= 232 * MiB && MOE_PASS_BLK * MOE_NPASS == MOE_CAP_BLK, "ws map");
constexpr int CW_TMO = 0, CW_CODE = 1, CW_BAR = 4096, CW_HIST = 16384;

constexpr int RING_BYTES = 150528;
constexpr int LDSCTL_OFF = RING_BYTES, MISC_OFF = LDSCTL_OFF + 320;
constexpr int LDS_BYTES = 155648;
static_assert(MISC_OFF + 256 <= LDS_BYTES && attn_body::LDS_ALL <= RING_BYTES, "LDS map");

struct Args { const float* in[31]; float* out; unsigned char* ws; };

struct Ctx {
    LAS unsigned char* lds; volatile LAS unsigned* MISC;
    int wave, vcu, G;
};
typedef const __attribute__((address_space(4))) unsigned char* kaptr;
DI kaptr kargs() { kaptr p = (kaptr)__builtin_amdgcn_kernarg_segment_ptr(); asm volatile("" : "+s"(p)); return p; }
DI const float* kin(int k) { return ((const float* const __attribute__((address_space(4)))*)kargs())[k]; }
DI float* kout() { return ((float* const __attribute__((address_space(4)))*)kargs())[31]; }
DI unsigned char* kws() { return ((unsigned char* const __attribute__((address_space(4)))*)kargs())[32]; }
DI gu32* kctl() { return (gu32*)(kws() + WS_CTL); }
#define PHASE_IDS const int tid = C.wave * 64 + lane_id_fresh(), lane = tid & 63, w = __builtin_amdgcn_readfirstlane(tid >> 6); int G_ = C.G, vcu_ = C.vcu; asm volatile("" : "+s"(G_), "+s"(vcu_)); const int G = G_, vcu = vcu_; (void)lane; (void)w; (void)G; (void)vcu;
DI float bf2f(unsigned short h) { return __uint_as_float((unsigned)h << 16); }
DI float silu_f(float x) { return x * __builtin_amdgcn_rcpf(1.f + __expf(-x)); }
DI float softplus_f(float x) { return x > 20.f ? x : log1pf(__expf(x)); }
DI float logsig_f(float x) { return -softplus_f(-x); }
#define SWZ_XOR(v, m) __int_as_float(__builtin_amdgcn_ds_swizzle(__float_as_int(v), (((m) << 10) | 0x1f)))
DI float wave_sum(float v) {
    v += SWZ_XOR(v, 1); v += SWZ_XOR(v, 2); v += SWZ_XOR(v, 4); v += SWZ_XOR(v, 8); v += SWZ_XOR(v, 16);
    auto rr = __builtin_amdgcn_permlane32_swap(__float_as_uint(v), __float_as_uint(v), false, false); return __uint_as_float(rr[0]) + __uint_as_float(rr[1]);
}
DI float wave_max(float v) {
    v = fmaxf(v, SWZ_XOR(v, 1)); v = fmaxf(v, SWZ_XOR(v, 2)); v = fmaxf(v, SWZ_XOR(v, 4)); v = fmaxf(v, SWZ_XOR(v, 8)); v = fmaxf(v, SWZ_XOR(v, 16));
    auto rr = __builtin_amdgcn_permlane32_swap(__float_as_uint(v), __float_as_uint(v), false, false); return fmaxf(__uint_as_float(rr[0]), __uint_as_float(rr[1]));
}
DI float wave_scan_incl(float v, int lane) {
#pragma unroll
    for (int o = 1; o < 64; o <<= 1) { const float x = __int_as_float(__builtin_amdgcn_ds_bpermute(((lane - o) & 63) << 2, __float_as_int(v))); if (lane >= o) v += x; }
    return v;
}
DI v4u pack8(const float (&v)[8]) { v4u o; o.x = pk2(v[0], v[1]); o.y = pk2(v[2], v[3]); o.z = pk2(v[4], v[5]); o.w = pk2(v[6], v[7]); return o; }
template <int K> DI f32x4 mma16(const LAS unsigned char* A, int pa, const LAS unsigned char* Bt, int pb, int lane) {
    const LAS unsigned char* ap = A + (lane & 15) * pa + (lane >> 4) * 16;
    const LAS unsigned char* bp = Bt + (lane & 15) * pb + (lane >> 4) * 16;
    f32x4 acc = {0.f, 0.f, 0.f, 0.f};
#pragma unroll
    for (int k = 0; k < K; k += 32) { const bf16x8 a = *(const LAS bf16x8*)(ap + 2 * k); const bf16x8 b = *(const LAS bf16x8*)(bp + 2 * k); acc = __builtin_amdgcn_mfma_f32_16x16x32_bf16(a, b, acc, 0, 0, 0); }
    return acc;
}

DI void conv_seg(const float* W, int ldw, int K, int ncols, bf16* WT, int grp, int gstride, int row_off, LAS float* scr, int gw, int NGW, int lane, int& rot) {
    const int nblk = ncols / 32, nitems = (K / 64) * nblk;
    int it0 = gw - rot % NGW; if (it0 < 0) it0 += NGW;
    rot += nitems;
    for (int it = it0; it < nitems; it += NGW) {
        const int kb = it / nblk, nb = it % nblk, k0 = 64 * kb, n0 = 32 * nb;
#pragma unroll 8
        for (int i = 0; i < 32; ++i) { const int kk = 2 * i + (lane >> 5); scr[kk * 33 + (lane & 31)] = W[(size_t)(k0 + kk) * ldw + n0 + (lane & 31)]; }
        LDS_WAIT(); asm volatile("" ::: "memory");
        const int c = lane & 7; const int drow0 = row_off + (n0 / grp) * gstride + n0 % grp;
#pragma unroll
        for (int j = 0; j < 4; ++j) { const int n = (lane >> 3) + 8 * j; const LAS float* s = scr + (8 * c) * 33 + n;
            v4u o; o.x = pk2(s[0 * 33], s[1 * 33]); o.y = pk2(s[2 * 33], s[3 * 33]); o.z = pk2(s[4 * 33], s[5 * 33]); o.w = pk2(s[6 * 33], s[7 * 33]);
            *(GAS v4u*)(WT + (size_t)(drow0 + n) * K + k0 + 8 * c) = o; }
        LDS_WAIT(); asm volatile("" ::: "memory");
    }
}
DI void cvt_rows(const float* src, bf16* dst, size_t n, int gt, int NGT) {
    for (size_t i = (size_t)gt * 8; i < n; i += (size_t)NGT * 8) { const f32x4 a = *(const GAS f32x4*)(src + i), b = *(const GAS f32x4*)(src + i + 4);
        v4u o; o.x = pk2(a.x, a.y); o.y = pk2(a.z, a.w); o.z = pk2(b.x, b.y); o.w = pk2(b.z, b.w); *(GAS v4u*)(dst + i) = o; }
}
DI void p0_prologue(Ctx& C) {
    PHASE_IDS
    LAS float* scr = (LAS float*)(C.lds + w * 16384);
    const int gw = vcu * NWAVES + w, NGW = G * NWAVES; int rot = 0;
    unsigned char* const ws = kws();
    for (int l = 0; l < DEPTH; ++l) {
        bf16* WL = (bf16*)(ws + WS_W + l * W_LAYER);
        const float* win = kin(2) + (size_t)l * DM * D_IN;
        bf16* WIN = (bf16*)((unsigned char*)WL + W_IN);
        conv_seg(win + 0, D_IN, DM, 512, WIN, 512, 512, HZ, scr, gw, NGW, lane, rot);
        conv_seg(win + 512, D_IN, DM, 1024, WIN, 1024, 1024, HXBC, scr, gw, NGW, lane, rot);
        conv_seg(win + 1544, D_IN, DM, 256, WIN, 256, 256, HQ, scr, gw, NGW, lane, rot);
        conv_seg(win + 1800, D_IN, DM, 256, WIN, 256, 256, HK, scr, gw, NGW, lane, rot);
        conv_seg(win + 2056, D_IN, DM, 256, WIN, 256, 256, HV, scr, gw, NGW, lane, rot);
        conv_seg(win + 2316, D_IN, DM, 256, WIN, 256, 256, HPOOL, scr, gw, NGW, lane, rot);
        conv_seg(kin(13) + (size_t)l * DM * DM, DM, DM, DM, (bf16*)((unsigned char*)WL + W_OUT), DM, DM, 0, scr, gw, NGW, lane, rot);
        conv_seg(kin(16) + (size_t)l * DM * DM, DM, DM, DM, (bf16*)((unsigned char*)WL + W_Q), DM, DM, 0, scr, gw, NGW, lane, rot);
        conv_seg(kin(19) + (size_t)l * DM * DM, DM, DM, DM, (bf16*)((unsigned char*)WL + W_O), DM, DM, 0, scr, gw, NGW, lane, rot);
        conv_seg(kin(17) + (size_t)l * DM * DM, DM, DM, DM, (bf16*)(ws + WS_W + W_K), DM, DM, l * DM, scr, gw, NGW, lane, rot);
        conv_seg(kin(18) + (size_t)l * DM * DM, DM, DM, DM, (bf16*)(ws + WS_W + W_V), DM, DM, l * DM, scr, gw, NGW, lane, rot);
    }
    for (int j = 0; j < 2; ++j) {
        bf16* W13 = (bf16*)(ws + WS_W + W_DENSE + j * W_FFN + W_13); bf16* W2 = (bf16*)(ws + WS_W + W_DENSE + j * W_FFN + W_2);
        conv_seg(kin(22) + (size_t)j * DM * D_FF, D_FF, DM, D_FF, W13, 128, 256, 0, scr, gw, NGW, lane, rot);
        conv_seg(kin(23) + (size_t)j * DM * D_FF, D_FF, DM, D_FF, W13, 128, 256, 128, scr, gw, NGW, lane, rot);
        conv_seg(kin(24) + (size_t)j * D_FF * DM, DM, D_FF, DM, W2, DM, DM, 0, scr, gw, NGW, lane, rot);
    }
    for (int je = 0; je < 2 * NEXP; ++je) {
        bf16* W13 = (bf16*)(ws + WS_W + W_MOE + je * W_FFN + W_13); bf16* W2 = (bf16*)(ws + WS_W + W_MOE + je * W_FFN + W_2);
        conv_seg(kin(26) + (size_t)je * DM * D_FF, D_FF, DM, D_FF, W13, 128, 256, 0, scr, gw, NGW, lane, rot);
        conv_seg(kin(27) + (size_t)je * DM * D_FF, D_FF, DM, D_FF, W13, 128, 256, 128, scr, gw, NGW, lane, rot);
        conv_seg(kin(28) + (size_t)je * D_FF * DM, DM, D_FF, DM, W2, DM, DM, 0, scr, gw, NGW, lane, rot);
    }
    const int gt = (vcu * NWAVES + w) * 64 + lane, NGT = G * NTHR;
    cvt_rows(kin(0), (bf16*)(ws + WS_XB), (size_t)NTOK * DM, gt, NGT);
    cvt_rows(kin(1), (bf16*)(ws + WS_MEMB), (size_t)NB * MEMLEN * DM, gt, NGT);
}

DI void skinny_phase(Ctx& C, int layer, const float* X) {
    PHASE_IDS
    LAS float* wsk = (LAS float*)C.lds;
    unsigned char* const ws = kws();
    const float* win = kin(2) + (size_t)layer * DM * D_IN;
    for (int idx = tid; idx < DM * 12; idx += NTHR) { const int k = idx / 12, j = idx % 12; wsk[idx] = win[(size_t)k * D_IN + (j < 8 ? 1536 + j : 2312 + (j - 8))]; }
    __syncthreads();
    float* DTF = (float*)(ws + WS_DTF);
    const int gw = vcu * NWAVES + w, NGW = G * NWAVES;
    for (int m = gw; m < NTOK; m += NGW) {
        const GAS f32x4* xr = (const GAS f32x4*)(X + (size_t)m * DM) + lane;
        float acc[12];
#pragma unroll
        for (int c = 0; c < 12; ++c) acc[c] = 0.f;
#pragma unroll
        for (int j = 0; j < 4; ++j) { const f32x4 v = xr[64 * j];
#pragma unroll
            for (int i = 0; i < 4; ++i) { const LAS f32x4* wp = (const LAS f32x4*)(wsk + (256 * j + 4 * lane + i) * 12); const f32x4 w0 = wp[0], w1 = wp[1], w2 = wp[2]; const float xv = v[i];
                acc[0] += xv * w0.x; acc[1] += xv * w0.y; acc[2] += xv * w0.z; acc[3] += xv * w0.w; acc[4] += xv * w1.x; acc[5] += xv * w1.y; acc[6] += xv * w1.z; acc[7] += xv * w1.w;
                acc[8] += xv * w2.x; acc[9] += xv * w2.y; acc[10] += xv * w2.z; acc[11] += xv * w2.w; } }
        float mine = 0.f;
#pragma unroll
        for (int c = 0; c < 12; ++c) { const float s = wave_sum(acc[c]); if (lane == c) mine = s; }
        if (lane < 12) DTF[(size_t)m * 12 + lane] = mine;
    }
    __syncthreads();
}
namespace pb {
constexpr int P72 = 144, P136 = 272;
constexpr int DT = 0, AC = 2048, BM_ = 4096, CMS = BM_ + 64 * P136, BMT = CMS + 64 * P136, CB = BMT + 128 * P72, XDT = CB + 64 * 65 * 4, XDD = XDT + 64 * P72, MH = XDD + 64 * P72, XS = MH + 64 * P72, END = XS + 64 * 65 * 4;
static_assert(END <= RING_BYTES && (BM_ % 16) == 0 && (CMS % 16) == 0 && (BMT % 16) == 0 && (XDT % 16) == 0 && (XDD % 16) == 0 && (MH % 16) == 0, "pb LDS map");
}
DI void conv8(const bf16* H, size_t row0, int tl0, int tb0, int hcol, const float* cw, const float* cb, int ch, float (&y)[8]) {
    float u[11];
#pragma unroll
    for (int i = 0; i < 11; ++i) u[i] = (tb0 - 3 + i >= 0) ? bf2f(H[(row0 + tl0 - 3 + i) * HC + hcol]) : 0.f;
    const float w0 = cw[ch], w1 = cw[1024 + ch], w2 = cw[2048 + ch], w3 = cw[3072 + ch], bias = cb[ch];
#pragma unroll
    for (int i = 0; i < 8; ++i) y[i] = silu_f(bias + w0 * u[i] + w1 * u[i + 1] + w2 * u[i + 2] + w3 * u[i + 3]);
}
DI void conv8x2(const bf16* H, size_t row0, int tl0, int tb0, int hcol, const float* cw, const float* cb, int ch, float (&y0)[8], float (&y1)[8]) {
    float u0[11], u1[11];
#pragma unroll
    for (int i = 0; i < 11; ++i) { unsigned w = 0u; if (tb0 - 3 + i >= 0) w = *(const unsigned*)(H + (row0 + tl0 - 3 + i) * HC + hcol); u0[i] = __uint_as_float(w << 16); u1[i] = __uint_as_float(w & 0xffff0000u); }
    const float a0 = cw[ch], a1 = cw[1024 + ch], a2 = cw[2048 + ch], a3 = cw[3072 + ch], ab = cb[ch];
    const float b0 = cw[ch + 1], b1 = cw[1024 + ch + 1], b2 = cw[2048 + ch + 1], b3 = cw[3072 + ch + 1], bb = cb[ch + 1];
#pragma unroll
    for (int i = 0; i < 8; ++i) { y0[i] = silu_f(ab + a0 * u0[i] + a1 * u0[i + 1] + a2 * u0[i + 2] + a3 * u0[i + 3]); y1[i] = silu_f(bb + b0 * u1[i] + b1 * u1[i + 1] + b2 * u1[i + 2] + b3 * u1[i + 3]); }
}
template <int W> DI void pool8(const bf16* H, size_t row0, int tl0, int tb0, int hcol, float (&y)[8]) {
    float u[23];
#pragma unroll
    for (int i = 16 - W; i < 23; ++i) u[i] = (tb0 - 15 + i >= 0) ? bf2f(H[(row0 + tl0 - 15 + i) * HC + hcol]) : 0.f;
#pragma unroll
    for (int i = 0; i < 8; ++i) { float s = 0.f;
#pragma unroll
        for (int j = 0; j < W; ++j) s += u[15 + i - j];
        const int tb = tb0 + i; const float cnt = (float)((tb + 1 < W) ? tb + 1 : W); y[i] = s / cnt - u[15 + i]; }
}
template <int PG> DI void pool_group(Ctx& C, const float* pw, const float* pbias, const float* pscale, const bf16* H, bf16* MIX, size_t row0, int c) {
    using namespace pb;
    constexpr int W = 2 << PG;
    PHASE_IDS
    LAS unsigned char* L = C.lds;
    { float y[8]; pool8<W>(H, row0, 8 * w, c * 64 + 8 * w, HPOOL + PG * 64 + lane, y);
#pragma unroll
        for (int i = 0; i < 8; ++i) *(LAS unsigned short*)(L + XDT + (8 * w + i) * P72 + lane * 2) = (unsigned short)f2bf(y[i]); }
    { const int cc = tid >> 3, d0 = (tid & 7) * 8; const float* src = pw + ((size_t)PG * 64 + cc) * 64 + d0;
        const f32x4 a = *(const GAS f32x4*)src, b = *(const GAS f32x4*)(src + 4); const float v[8] = {a.x, a.y, a.z, a.w, b.x, b.y, b.z, b.w};
#pragma unroll
        for (int i = 0; i < 8; ++i) *(LAS unsigned short*)(L + XDD + (d0 + i) * P72 + cc * 2) = (unsigned short)f2bf(v[i]); }
    __syncthreads();
#pragma unroll
    for (int q = 0; q < 2; ++q) { const int tt = 2 * w + q, tb_ = tt >> 2, db = tt & 3;
        const f32x4 acc = mma16<64>(L + XDT + tb_ * 16 * P72, P72, L + XDD + db * 16 * P72, P72, lane);
        const int d = db * 16 + (lane & 15); const float pbv = pbias[PG * 64 + d], psc = pscale[PG * 64 + d];
#pragma unroll
        for (int r = 0; r < 4; ++r) { const int t = tb_ * 16 + (lane >> 4) * 4 + r; MIX[(row0 + t) * DM + 768 + PG * 64 + d] = (bf16)f2bf((acc[r] + pbv) * psc); } }
    __syncthreads();
}
DI void ssd_local_phase(Ctx& C, int layer) {
    using namespace pb;
    unsigned char* const ws = kws();
    const float* dtb = kin(5) + layer * 8; const float* alog = kin(6) + layer * 8; const float* dsk = kin(7) + layer * 8; const float* fbias = kin(9) + layer * 4;
    const float* pw = kin(10) + (size_t)layer * 4 * 64 * 64; const float* pbias = kin(11) + layer * 256; const float* pscale = kin(12) + layer * 256;
    const bf16* H = (const bf16*)(ws + WS_BIG); bf16* MIX = (bf16*)(ws + WS_MIX); bf16* CMG = (bf16*)(ws + WS_CM);
    const float* DTF = (const float*)(ws + WS_DTF); float* GACS = (float*)(ws + WS_GACS); float* FOXC = (float*)(ws + WS_FOXC); float* FOXT = (float*)(ws + WS_FOXT);
    float* CDEC = (float*)(ws + WS_CDEC); float* ST = (float*)(ws + WS_ST);
    const float* cw = kin(3) + (size_t)layer * 4 * 1024; const float* cb = kin(4) + (size_t)layer * 1024;
    PHASE_IDS
    LAS unsigned char* L = C.lds;
    LAS float* sDT = (LAS float*)(L + DT); LAS float* sAC = (LAS float*)(L + AC); LAS float* sCB = (LAS float*)(L + CB); LAS float* sXS = (LAS float*)(L + XS);
    for (int u = vcu; u < NB * NCH; u += G) {
        const int b = u >> 8, c = u & 255; const size_t row0 = (size_t)b * SEQ + (size_t)c * 64;
        { const int t = tid >> 3, h = tid & 7; const float dtv = softplus_f(DTF[(row0 + t) * 12 + h] + dtb[h]); sDT[t * 8 + h] = dtv; sAC[t * 8 + h] = dtv * (-__expf(alog[h])); }
        __syncthreads();
        { const float v = wave_scan_incl(sAC[lane * 8 + w], lane); sAC[lane * 8 + w] = v; GACS[(row0 + lane) * 8 + w] = v; if (lane == 63) CDEC[((size_t)b * NCH + c) * 8 + w] = __expf(v); }
        if (w < 4) { const float v = wave_scan_incl(logsig_f(DTF[(row0 + lane) * 12 + 8 + w] + fbias[w]), lane);
            FOXC[((size_t)b * 4 + w) * SEQ + c * 64 + lane] = v; if (lane == 63) FOXT[((size_t)b * 4 + w) * NCH + c] = v; }
        __syncthreads();
        for (int g = 0; g < 2; ++g) {
            { float y0[8], y1[8];
              conv8x2(H, row0, 8 * w, c * 64 + 8 * w, HXBC + 512 + g * 128 + 2 * lane, cw, cb, 512 + g * 128 + 2 * lane, y0, y1);
#pragma unroll
              for (int i = 0; i < 8; ++i) *(LAS unsigned*)(L + BM_ + (8 * w + i) * P136 + lane * 4) = pk2(y0[i], y1[i]);
              *(LAS v4u*)(L + BMT + (2 * lane) * P72 + 16 * w) = pack8(y0); *(LAS v4u*)(L + BMT + (2 * lane + 1) * P72 + 16 * w) = pack8(y1);
              conv8x2(H, row0, 8 * w, c * 64 + 8 * w, HXBC + 768 + g * 128 + 2 * lane, cw, cb, 768 + g * 128 + 2 * lane, y0, y1);
#pragma unroll
              for (int i = 0; i < 8; ++i) { const unsigned pk = pk2(y0[i], y1[i]); *(LAS unsigned*)(L + CMS + (8 * w + i) * P136 + lane * 4) = pk; *(unsigned*)(CMG + (row0 + 8 * w + i) * 256 + g * 128 + 2 * lane) = pk; } }
            __syncthreads();
#pragma unroll
            for (int q = 0; q < 2; ++q) { const int tt = 2 * w + q, lb = tt >> 2, sb = tt & 3;
                const f32x4 acc = mma16<128>(L + CMS + lb * 16 * P136, P136, L + BM_ + sb * 16 * P136, P136, lane);
#pragma unroll
                for (int r = 0; r < 4; ++r) sCB[(lb * 16 + (lane >> 4) * 4 + r) * 65 + sb * 16 + (lane & 15)] = acc[r]; }
            __syncthreads();
            for (int rr = 0; rr < 4; ++rr) { const int h = 4 * g + rr;
                { float xv[8]; conv8(H, row0, 8 * w, c * 64 + 8 * w, HXBC + h * 64 + lane, cw, cb, h * 64 + lane, xv);
                  const float Dh = dsk[h], a63 = sAC[63 * 8 + h]; float xdt[8], xdd[8];
#pragma unroll
                  for (int i = 0; i < 8; ++i) { const int t = 8 * w + i; sXS[t * 65 + lane] = xv[i] * Dh; xdt[i] = xv[i] * sDT[t * 8 + h]; xdd[i] = xdt[i] * __expf(a63 - sAC[t * 8 + h]); }
                  *(LAS v4u*)(L + XDT + lane * P72 + 16 * w) = pack8(xdt); *(LAS v4u*)(L + XDD + lane * P72 + 16 * w) = pack8(xdd); }
                { const int l = tid >> 3, s0 = (tid & 7) * 8; const float al = sAC[l * 8 + h]; float m[8];
#pragma unroll
                  for (int i = 0; i < 8; ++i) { const int s = s0 + i; m[i] = (s <= l) ? sCB[l * 65 + s] * __expf(al - sAC[s * 8 + h]) : 0.f; }
                  *(LAS v4u*)(L + MH + l * P72 + 2 * s0) = pack8(m); }
                __syncthreads();
#pragma unroll
                for (int q = 0; q < 2; ++q) { const int tt = 2 * w + q, lb = tt >> 2, pb_ = tt & 3;
                    const f32x4 acc = mma16<64>(L + MH + lb * 16 * P72, P72, L + XDT + pb_ * 16 * P72, P72, lane);
                    const int p = pb_ * 16 + (lane & 15);
#pragma unroll
                    for (int r = 0; r < 4; ++r) { const int l = lb * 16 + (lane >> 4) * 4 + r; MIX[(row0 + l) * DM + h * 64 + p] = (bf16)f2bf(acc[r] + sXS[l * 65 + p]); } }
                { float* stp = ST + (((size_t)b * NCH + c) * 8 + h) * 8192; const int pb_ = w & 3;
#pragma unroll
                  for (int q = 0; q < 4; ++q) { const int nb = (w >> 2) * 4 + q;
                      const f32x4 acc = mma16<64>(L + XDD + pb_ * 16 * P72, P72, L + BMT + nb * 16 * P72, P72, lane);
                      const int n = nb * 16 + (lane & 15);
#pragma unroll
                      for (int r = 0; r < 4; ++r) { const int p = pb_ * 16 + (lane >> 4) * 4 + r; stp[p * 128 + n] = acc[r]; } } }
                __syncthreads();
            }
        }
        pool_group<0>(C, pw, pbias, pscale, H, MIX, row0, c); pool_group<1>(C, pw, pbias, pscale, H, MIX, row0, c); pool_group<2>(C, pw, pbias, pscale, H, MIX, row0, c); pool_group<3>(C, pw, pbias, pscale, H, MIX, row0, c);
    }
}
DI void ssd_scan_phase(Ctx& C) {
    PHASE_IDS
    unsigned char* const ws = kws();
    float* __restrict__ ST = (float*)(ws + WS_ST); const float* __restrict__ CDEC = (const float*)(ws + WS_CDEC);
    for (int e = vcu * NTHR + tid; e < NB * 65536; e += G * NTHR) {
        const int b = e >> 16, rem = e & 65535, h = rem >> 13;
        float* p = ST + (size_t)b * NCH * 65536 + rem; const float* dc = CDEC + (size_t)b * NCH * 8 + h; float hs = 0.f;
#pragma unroll 8
        for (int c = 0; c < NCH; ++c) { const float s = p[(size_t)c * 65536]; p[(size_t)c * 65536] = hs; hs = hs * dc[c * 8] + s; }
    }
}
namespace pd { constexpr int CMS = 0, PV = 64 * 272, ACS = PV + 64 * 272, YG = ACS + 2048, END = YG + 64 * 257 * 4; static_assert(END <= RING_BYTES, "pd LDS map"); }
DI void ssd_final_phase(Ctx& C, int layer) {
    using namespace pd; constexpr int P136 = 272;
    unsigned char* const ws = kws();
    const bf16* H = (const bf16*)(ws + WS_BIG); bf16* MIX = (bf16*)(ws + WS_MIX); const bf16* CMG = (const bf16*)(ws + WS_CM);
    const float* GACS = (const float*)(ws + WS_GACS); const float* ST = (const float*)(ws + WS_ST);
    const float* nw = kin(8) + (size_t)layer * 512;
    PHASE_IDS
    LAS unsigned char* L = C.lds; LAS float* sAC = (LAS float*)(L + ACS); LAS float* sYG = (LAS float*)(L + YG);
    for (int u = vcu; u < NB * NCH; u += G) {
        const int b = u >> 8, c = u & 255; const size_t row0 = (size_t)b * SEQ + (size_t)c * 64;
        sAC[tid] = GACS[row0 * 8 + tid];
        for (int g = 0; g < 2; ++g) {
            { const int t = tid >> 3, n0 = (tid & 7) * 16; const v4u* src = (const v4u*)(CMG + (row0 + t) * 256 + g * 128 + n0);
              *(LAS v4u*)(L + CMS + t * P136 + n0 * 2) = src[0]; *(LAS v4u*)(L + CMS + t * P136 + n0 * 2 + 16) = src[1]; }
            for (int rr = 0; rr < 4; ++rr) { const int h = 4 * g + rr;
                { const int p = tid >> 3, n0 = (tid & 7) * 16; const float* src = ST + (((size_t)b * NCH + c) * 8 + h) * 8192 + p * 128 + n0;
                  const f32x4 a = *(const GAS f32x4*)src, b4 = *(const GAS f32x4*)(src + 4), c4 = *(const GAS f32x4*)(src + 8), d4 = *(const GAS f32x4*)(src + 12);
                  v4u o0, o1; o0.x = pk2(a.x, a.y); o0.y = pk2(a.z, a.w); o0.z = pk2(b4.x, b4.y); o0.w = pk2(b4.z, b4.w); o1.x = pk2(c4.x, c4.y); o1.y = pk2(c4.z, c4.w); o1.z = pk2(d4.x, d4.y); o1.w = pk2(d4.z, d4.w);
                  *(LAS v4u*)(L + PV + p * P136 + n0 * 2) = o0; *(LAS v4u*)(L + PV + p * P136 + n0 * 2 + 16) = o1; }
                __syncthreads();
#pragma unroll
                for (int q = 0; q < 2; ++q) { const int tt = 2 * w + q, lb = tt >> 2, pb_ = tt & 3;
                    const f32x4 acc = mma16<128>(L + CMS + lb * 16 * P136, P136, L + PV + pb_ * 16 * P136, P136, lane);
                    const int p = pb_ * 16 + (lane & 15);
#pragma unroll
                    for (int r = 0; r < 4; ++r) { const int l = lb * 16 + (lane >> 4) * 4 + r;
                        const float y = bf2f(MIX[(row0 + l) * DM + h * 64 + p]) + acc[r] * __expf(sAC[l * 8 + h]);
                        const float z = bf2f(H[(row0 + l) * HC + HZ + h * 64 + p]);
                        sYG[l * 257 + rr * 64 + p] = y * silu_f(z); } }
                __syncthreads();
            }
#pragma unroll
            for (int i = 0; i < 8; ++i) { const int t = 8 * w + i; const LAS float* yr = sYG + t * 257 + 4 * lane; const float y0 = yr[0], y1 = yr[1], y2 = yr[2], y3 = yr[3];
                const float ss = wave_sum((y0 * y0 + y1 * y1) + (y2 * y2 + y3 * y3)); const float rs = 1.0f / sqrtf(ss * (1.f / 256.f) + RMS_EPS);
                const f32x4 nv = *(const GAS f32x4*)(nw + g * 256 + 4 * lane);
                unsigned long long o = (unsigned long long)pk2(y0 * rs * nv.x, y1 * rs * nv.y) | ((unsigned long long)pk2(y2 * rs * nv.z, y3 * rs * nv.w) << 32);
                *(unsigned long long*)(MIX + (row0 + t) * DM + g * 256 + 4 * lane) = o; }
            __syncthreads();
        }
    }
}
template <int MODE, bool ROUTE> DI void ln_phase(Ctx& C, const float* src, const float* gam, const float* bet, int moe_j) {
    unsigned char* const ws = kws(); gu32* const ctl = (gu32*)(ws + WS_CTL);
    float* X = kout(); bf16* XB = (bf16*)(ws + WS_XB);
    PHASE_IDS
    const int gw = vcu * NWAVES + w, NGW = G * NWAVES;
    LAS float* rw = (LAS float*)C.lds;
    if (ROUTE) { const float* r = kin(25) + (size_t)moe_j * DM * NEXP; for (int i = tid; i < DM * NEXP; i += NTHR) rw[i] = r[i]; __syncthreads(); }
    f32x4 gv[4], bv[4];
#pragma unroll
    for (int j = 0; j < 4; ++j) { gv[j] = *(const GAS f32x4*)(gam + 256 * j + 4 * lane); bv[j] = *(const GAS f32x4*)(bet + 256 * j + 4 * lane); }
    const int* TOKS = (const int*)(ws + WS_TOKS); const float* TOKG = (const float*)(ws + WS_TOKG); const bf16* Y = (const bf16*)(ws + WS_Y);
    int* TOKE = (int*)(ws + WS_TOKE); float* TOKGw = (float*)(ws + WS_TOKG); unsigned* HIST = (unsigned*)(ctl + CW_HIST) + moe_j * 128 * NEXP;
    for (int m = gw; m < NTOK; m += NGW) {
        const GAS f32x4* xr = (const GAS f32x4*)(src + (size_t)m * DM) + lane;
        f32x4 v[4];
#pragma unroll
        for (int j = 0; j < 4; ++j) v[j] = xr[64 * j];
        if (MODE == 1) { const int s0 = TOKS[2 * m], s1 = TOKS[2 * m + 1]; const float g0 = TOKG[2 * m], g1 = TOKG[2 * m + 1];
            const GAS unsigned long long* y0 = (const GAS unsigned long long*)(Y + (size_t)s0 * DM) + lane; const GAS unsigned long long* y1 = (const GAS unsigned long long*)(Y + (size_t)s1 * DM) + lane;
#pragma unroll
            for (int j = 0; j < 4; ++j) { const unsigned long long a = y0[64 * j], b = y1[64 * j];
                const f32x4 ya = {__uint_as_float((unsigned)a << 16), __uint_as_float((unsigned)a & 0xffff0000u), __uint_as_float((unsigned)(a >> 32) << 16), __uint_as_float((unsigned)(a >> 32) & 0xffff0000u)};
                const f32x4 yb = {__uint_as_float((unsigned)b << 16), __uint_as_float((unsigned)b & 0xffff0000u), __uint_as_float((unsigned)(b >> 32) << 16), __uint_as_float((unsigned)(b >> 32) & 0xffff0000u)};
                v[j] = v[j] * DN_ALPHA + ya * g0 + yb * g1; } }
        float s = 0.f;
#pragma unroll
        for (int j = 0; j < 4; ++j) s += (v[j].x + v[j].y) + (v[j].z + v[j].w);
        const float mean = wave_sum(s) * (1.f / DM); float s2 = 0.f;
#pragma unroll
        for (int j = 0; j < 4; ++j) { v[j] = v[j] - mean; s2 += (v[j].x * v[j].x + v[j].y * v[j].y) + (v[j].z * v[j].z + v[j].w * v[j].w); }
        const float rstd = 1.f / sqrtf(wave_sum(s2) * (1.f / DM) + LN_EPS);
        GAS f32x4* xo = (GAS f32x4*)(X + (size_t)m * DM) + lane; GAS unsigned long long* o8 = (GAS unsigned long long*)(XB + (size_t)m * DM) + lane;
#pragma unroll
        for (int j = 0; j < 4; ++j) { v[j] = v[j] * rstd * gv[j] + bv[j]; xo[64 * j] = v[j]; o8[64 * j] = (unsigned long long)pk2(v[j].x, v[j].y) | ((unsigned long long)pk2(v[j].z, v[j].w) << 32); }
        if (ROUTE) {
            float lg[8];
#pragma unroll
            for (int e = 0; e < 8; ++e) lg[e] = 0.f;
#pragma unroll
            for (int j = 0; j < 4; ++j)
#pragma unroll
                for (int i = 0; i < 4; ++i) { const LAS f32x4* wp = (const LAS f32x4*)(rw + (256 * j + 4 * lane + i) * 8); const f32x4 w0 = wp[0], w1 = wp[1]; const float xv = v[j][i];
                    lg[0] += xv * w0.x; lg[1] += xv * w0.y; lg[2] += xv * w0.z; lg[3] += xv * w0.w; lg[4] += xv * w1.x; lg[5] += xv * w1.y; lg[6] += xv * w1.z; lg[7] += xv * w1.w; }
#pragma unroll
            for (int e = 0; e < 8; ++e) lg[e] = wave_sum(lg[e]);
            if (lane == 0) { int e0 = 0; float v0 = lg[0];
#pragma unroll
                for (int e = 1; e < 8; ++e) if (lg[e] > v0) { v0 = lg[e]; e0 = e; }
                int e1 = -1; float v1 = -INFINITY;
#pragma unroll
                for (int e = 0; e < 8; ++e) if (e != e0 && lg[e] > v1) { v1 = lg[e]; e1 = e; }
                const float ex = __expf(v1 - v0), g0 = 1.f / (1.f + ex), g1 = ex / (1.f + ex);
                TOKE[2 * m] = e0; TOKE[2 * m + 1] = e1; TOKGw[2 * m] = g0; TOKGw[2 * m + 1] = g1;
                __hip_atomic_fetch_add(HIST + (m >> 8) * NEXP + e0, 1u, RLX_AGENT); __hip_atomic_fetch_add(HIST + (m >> 8) * NEXP + e1, 1u, RLX_AGENT); }
        }
    }
    if (ROUTE) __syncthreads();
}
DI void xsoftmax_phase(Ctx& C) {
    unsigned char* const ws = kws();
    const float* S = (const float*)(ws + WS_BIG + 64 * MiB); bf16* P = (bf16*)(ws + WS_ST);
    PHASE_IDS
    const int gw = vcu * NWAVES + w, NGW = G * NWAVES;
    for (int m = gw; m < NTOK; m += NGW) {
        const GAS f32x4* sr = (const GAS f32x4*)(S + (size_t)m * DM) + lane; GAS unsigned long long* o8 = (GAS unsigned long long*)(P + (size_t)m * DM) + lane;
#pragma unroll
        for (int h = 0; h < 4; ++h) { f32x4 v = sr[64 * h]; const float mx = wave_max(fmaxf(fmaxf(v.x, v.y), fmaxf(v.z, v.w)));
            v.x = __expf(v.x - mx); v.y = __expf(v.y - mx); v.z = __expf(v.z - mx); v.w = __expf(v.w - mx);
            const float inv = 1.f / wave_sum((v.x + v.y) + (v.z + v.w)); v = v * inv;
            o8[64 * h] = (unsigned long long)pk2(v.x, v.y) | ((unsigned long long)pk2(v.z, v.w) << 32); }
    }
}
DI void moe_meta(Ctx& C, int moe_j, int (&pend)[8], int (&tot)[8]) {
    PHASE_IDS
    gu32* const ctl = kctl();
    volatile LAS unsigned* sc = C.MISC + 16; const unsigned* HIST = (const unsigned*)(ctl + CW_HIST) + moe_j * 128 * NEXP;
    __syncthreads();
    if (tid < 8) sc[tid] = 0u;
    __syncthreads();
    { const int i = tid >> 3, e = tid & 7; const unsigned v = __hip_atomic_load(HIST + i * NEXP + e, RLX_AGENT) + __hip_atomic_load(HIST + (i + 64) * NEXP + e, RLX_AGENT); __hip_atomic_fetch_add((LAS unsigned*)(sc + e), v, __ATOMIC_RELAXED, __HIP_MEMORY_SCOPE_WORKGROUP); }
    __syncthreads();
    int run = 0;
#pragma unroll
    for (int e = 0; e < 8; ++e) { tot[e] = (int)sc[e]; run += (tot[e] + 255) >> 8; pend[e] = run; }
    __syncthreads();
}
DI void moe_assign_phase(Ctx& C, int moe_j) {
    int pend[8], tot[8]; moe_meta(C, moe_j, pend, tot);
    unsigned char* const ws = kws(); gu32* const ctl = (gu32*)(ws + WS_CTL);
    const unsigned* HIST = (const unsigned*)(ctl + CW_HIST) + moe_j * 128 * NEXP;
    const int* TOKE = (const int*)(ws + WS_TOKE); int* TOKS = (int*)(ws + WS_TOKS);
    const bf16* XB = (const bf16*)(ws + WS_XB); bf16* XG = (bf16*)(ws + WS_ST);
    LAS int* sBef = (LAS int*)C.lds; LAS int* sWc = sBef + 8; LAS int* sDst = sWc + 64;
    PHASE_IDS
    for (int blk = vcu; blk < NTOK / 256; blk += G) {
        if (tid < 8) sBef[tid] = 0;
        __syncthreads();
        { const int i = tid >> 3, e = tid & 7; int v = 0; if (i < blk) v += (int)__hip_atomic_load(HIST + i * NEXP + e, RLX_AGENT); if (i + 64 < blk) v += (int)__hip_atomic_load(HIST + (i + 64) * NEXP + e, RLX_AGENT); __hip_atomic_fetch_add(sBef + e, v, __ATOMIC_RELAXED, __HIP_MEMORY_SCOPE_WORKGROUP); }
        int e0 = -1, e1 = -1; const int t = blk * 256 + tid;
        if (tid < 256) { e0 = TOKE[2 * t]; e1 = TOKE[2 * t + 1]; }
        unsigned long long mk[8];
#pragma unroll
        for (int e = 0; e < 8; ++e) { mk[e] = __ballot(e0 == e || e1 == e); if (w < 4 && lane == 0) sWc[w * 8 + e] = __popcll(mk[e]); }
        __syncthreads();
        if (tid < 256) { const unsigned long long lt = (1ull << lane) - 1ull;
#pragma unroll
            for (int k = 0; k < 2; ++k) { const int ek = k ? e1 : e0; int rank = 0, base = 0;
#pragma unroll
                for (int e = 0; e < 8; ++e) if (e == ek) { rank = __popcll(mk[e] & lt); for (int ww = 0; ww < w; ++ww) rank += sWc[ww * 8 + e]; base = (e ? pend[e - 1] : 0) * 256 + sBef[e]; }
                const int dest = base + rank; TOKS[2 * t + k] = dest; sDst[2 * tid + k] = dest; } }
        __syncthreads();
        for (int r = w; r < 512; r += NWAVES) { const int tt = blk * 256 + (r >> 1); const v4u* s = (const v4u*)(XB + (size_t)tt * DM) + lane; v4u* d = (v4u*)(XG + (size_t)sDst[r] * DM) + lane; d[0] = s[0]; d[64] = s[64]; }
        __syncthreads();
    }
}
#define GRID_BAR() xcd_barrier(bar)
#define ws kws()
#define XB ((bf16*)(kws() + WS_XB))
#define MIX ((bf16*)(kws() + WS_MIX))
#define H ((bf16*)(kws() + WS_BIG))
template <int layer> DI void run_layer(Ctx& C, const XcdBarrier& bar, unsigned char* lds, const int bx) {
        const unsigned char* WL = ws + WS_W + (size_t)layer * W_LAYER;
#define Xsrc (layer == 0 ? kin(0) : (const float*)kout())
        { pg8::SchedStd S; S.init(NTOK / 256, HC / 256, C.G, bx, XB, DM, WL + W_IN, DM);
          pg8::EpiBf16S E{(pg8::bf16_t*)H, HC, HQ / 256, attn_body::C2, 0};
          pg8::gemm_phase<pg8::EpiBf16S, pg8::SchedStd, true, true>(C.lds, C.wave, DM, DM, DM, S, E); }
#ifndef NO_SKINNY
        skinny_phase(C, layer, Xsrc);
#endif

        GRID_BAR();
#ifndef NO_SSDL
        ssd_local_phase(C, layer);
#endif

        GRID_BAR();
#ifndef NO_SCAN
        ssd_scan_phase(C);
#endif

        __syncthreads();
        { const attn_body::AttnTensors AT{(const attn_body::bf16*)(H + HQ), (const attn_body::bf16*)(H + HK), (const attn_body::bf16*)(H + HV), (attn_body::bf16*)(MIX + 512),
                                          (const float*)(ws + WS_FOXC), (const float*)(ws + WS_FOXT)};
          const attn_body::StaticOrder S((int)C.G, bx);
#ifndef NO_ATTN
          attn_body::attn_phase<attn_body::StaticOrder>((char*)lds, C.wave, AT, S);
#endif
          (void)AT; (void)S; }

        GRID_BAR();
#ifndef NO_SSDF
        ssd_final_phase(C, layer);
#endif

        GRID_BAR();
        { pg8::SchedStd S; S.init(NTOK / 256, DM / 256, C.G, bx, MIX, DM, WL + W_OUT, DM);
          pg8::EpiResid E{Xsrc, kout(), DM, DN_ALPHA};
          pg8::gemm_phase<pg8::EpiResid, pg8::SchedStd, true, true>(C.lds, C.wave, DM, DM, DM, S, E); }
        GRID_BAR();
        ln_phase<0, false>(C, kout(), kin(14) + layer * DM, kin(15) + layer * DM, 0);
        GRID_BAR();
        { pg8::SchedStd S; S.init(NTOK / 256, DM / 256, C.G, bx, XB, DM, WL + W_Q, DM);
          pg8::EpiBf16S E{(pg8::bf16_t*)(ws + WS_BIG), DM, -1, 0.0625f, 0};
          pg8::gemm_phase<pg8::EpiBf16S, pg8::SchedStd, true, true>(C.lds, C.wave, DM, DM, DM, S, E); }
        GRID_BAR();
        { pg8::SchedXA S{C.G, bx, (const char*)(ws + WS_BIG), (const char*)(ws + WS_KC) + (size_t)layer * DM * 2, (size_t)256 * DM * 2, (size_t)256 * 4096 * 2, (size_t)256 * 2};
          pg8::EpiResid E{nullptr, (float*)(ws + WS_BIG + 64 * MiB), DM, 0.f};
          pg8::gemm_phase<pg8::EpiResid, pg8::SchedXA, true, true>(C.lds, C.wave, 256, DM, 4096, S, E); }
        GRID_BAR();
#ifndef NO_XSM
        xsoftmax_phase(C);
#endif

        GRID_BAR();
        { pg8::SchedXA S{C.G, bx, (const char*)(ws + WS_ST), (const char*)(ws + WS_VT) + (size_t)layer * DM * 512 * 2, (size_t)256 * DM * 2, (size_t)256 * 2, (size_t)256 * 512 * 2};
          pg8::EpiBf16S E{(pg8::bf16_t*)MIX, DM, -1, 1.f, 0};
          pg8::gemm_phase<pg8::EpiBf16S, pg8::SchedXA, true, true>(C.lds, C.wave, 256, DM, 512, S, E); }
        GRID_BAR();
        { pg8::SchedStd S; S.init(NTOK / 256, DM / 256, C.G, bx, MIX, DM, WL + W_O, DM);
          pg8::EpiResid E{kout(), kout(), DM, DN_ALPHA};
          pg8::gemm_phase<pg8::EpiResid, pg8::SchedStd, true, true>(C.lds, C.wave, DM, DM, DM, S, E); }
        GRID_BAR();
        const int j = layer >> 1;
        if constexpr ((layer & 1) == 0) {
            ln_phase<0, false>(C, kout(), kin(20) + layer * DM, kin(21) + layer * DM, 0);
            GRID_BAR();
            const unsigned char* WF = ws + WS_W + W_DENSE + (size_t)j * W_FFN;
            { pg8::SchedStd S; S.init(NTOK / 256, 2 * D_FF / 256, C.G, bx, XB, DM, WF + W_13, DM);
              pg8::EpiSwiglu E{(pg8::bf16_t*)(ws + WS_BIG), D_FF, 0};
              pg8::gemm_phase<pg8::EpiSwiglu, pg8::SchedStd, true, true>(C.lds, C.wave, DM, DM, DM, S, E); }
            GRID_BAR();
            { pg8::SchedStd S; S.init(NTOK / 256, DM / 256, C.G, bx, ws + WS_BIG, D_FF, WF + W_2, D_FF);
              pg8::EpiResid E{kout(), kout(), DM, DN_ALPHA};
              pg8::gemm_phase<pg8::EpiResid, pg8::SchedStd, true, true>(C.lds, C.wave, D_FF, D_FF, D_FF, S, E); }
            GRID_BAR();
            ln_phase<0, false>(C, kout(), kin(29) + layer * DM, kin(30) + layer * DM, 0);
            GRID_BAR();
        } else {
            ln_phase<0, true>(C, kout(), kin(20) + layer * DM, kin(21) + layer * DM, j);
            GRID_BAR();
#ifndef NO_ASSIGN
            moe_assign_phase(C, j);
#endif

            GRID_BAR();
            int pend[8], tot[8]; moe_meta(C, j, pend, tot);
            const unsigned char* WM = ws + WS_W + W_MOE + (size_t)j * NEXP * W_FFN;
            for (int ps = 0; ps < MOE_NPASS; ++ps) {
                const int lo = ps * MOE_PASS_BLK; int nM = pend[7] - lo; nM = nM < 0 ? 0 : (nM > MOE_PASS_BLK ? MOE_PASS_BLK : nM);
                { pg8::SchedMoE S; S.nM = nM; S.nN = 2 * D_FF / 256; S.nwg = nM * S.nN; S.G = C.G; S.c = bx; S.lo = lo; S.a_sub = 0;
#pragma unroll
                  for (int e = 0; e < 8; ++e) S.pend[e] = pend[e];
                  S.A = (const char*)(ws + WS_ST); S.B = (const char*)(WM + W_13); S.tA = (size_t)256 * DM * 2; S.tB = (size_t)256 * DM * 2; S.sE = W_FFN;
                  pg8::EpiSwiglu E{(pg8::bf16_t*)(ws + WS_HIDM), D_FF, lo};
                  pg8::gemm_phase<pg8::EpiSwiglu, pg8::SchedMoE, true, true>(C.lds, C.wave, DM, DM, DM, S, E); }
                GRID_BAR();
                { pg8::SchedMoE S; S.nM = nM; S.nN = DM / 256; S.nwg = nM * S.nN; S.G = C.G; S.c = bx; S.lo = lo; S.a_sub = lo;
#pragma unroll
                  for (int e = 0; e < 8; ++e) S.pend[e] = pend[e];
                  S.A = (const char*)(ws + WS_HIDM); S.B = (const char*)(WM + W_2); S.tA = (size_t)256 * D_FF * 2; S.tB = (size_t)256 * D_FF * 2; S.sE = W_FFN;
                  pg8::EpiBf16S E{(pg8::bf16_t*)(ws + WS_Y), DM, -1, 1.f, 0};
                  pg8::gemm_phase<pg8::EpiBf16S, pg8::SchedMoE, true, true>(C.lds, C.wave, D_FF, D_FF, D_FF, S, E); }
                GRID_BAR();
            }
            ln_phase<1, false>(C, kout(), kin(29) + layer * DM, kin(30) + layer * DM, 0);
            GRID_BAR();
        }
    }
__global__ void __launch_bounds__(NTHR, 2) fwd_kernel(Args args) {
    extern __shared__ __attribute__((aligned(16))) unsigned char lds[];
    Ctx C;
    C.lds = (LAS unsigned char*)lds; C.MISC = (volatile LAS unsigned*)(C.lds + MISC_OFF);
    C.wave = __builtin_amdgcn_readfirstlane((int)threadIdx.x >> 6);
    C.G = gridDim.x; { const int bx = blockIdx.x; C.vcu = (C.G % 8 == 0) ? (bx % 8) * (C.G / 8) + bx / 8 : bx; }
    for (int u = threadIdx.x; u < (LDS_BYTES - LDSCTL_OFF) / 4; u += NTHR) ((LAS unsigned*)(C.lds + LDSCTL_OFF))[u] = 0u;
    __syncthreads();
    XcdBarrier bar = xcd_barrier_post((unsigned*)(kctl() + CW_BAR), C.MISC + 8, C.wave);
    const int bx = (int)blockIdx.x;

#ifndef NO_P0
    p0_prologue(C);
#endif

    GRID_BAR();
    { pg8::SchedStd S; S.init(2, 16, C.G, bx, ws + WS_MEMB, DM, ws + WS_W + W_K, DM);
      pg8::EpiBf16S E{(pg8::bf16_t*)(ws + WS_KC), 4096, -1, 1.f, 0};
      pg8::gemm_phase<pg8::EpiBf16S, pg8::SchedStd, true, true>(C.lds, C.wave, DM, DM, DM, S, E); }
    { pg8::SchedStd S; S.init(16, 2, C.G, bx, ws + WS_W + W_V, DM, ws + WS_MEMB, DM);
      pg8::EpiBf16S E{(pg8::bf16_t*)(ws + WS_VT), 512, -1, 1.f, 0};
      pg8::gemm_phase<pg8::EpiBf16S, pg8::SchedStd, true, true>(C.lds, C.wave, DM, DM, DM, S, E); }

    run_layer<0>(C, bar, lds, bx); run_layer<1>(C, bar, lds, bx); run_layer<2>(C, bar, lds, bx); run_layer<3>(C, bar, lds, bx);
#undef GRID_BAR
#undef ws
#undef Xsrc
#undef XB
#undef MIX
#undef H
}

extern "C" void kernel_launch(void* const* d_in, const int* in_sizes, int n_in, void* d_out, int out_size, void* d_ws, size_t ws_size, hipStream_t stream) {
    static int grid = 0;
    if (grid == 0) {
        if (n_in != 31 || in_sizes[0] != NTOK * DM || out_size != NTOK * DM || ws_size < WS_END) {
            fprintf(stderr, "kernel_launch: built for 31 inputs, x/out of %d floats, >= %zu bytes of workspace; got n_in %d, in0 %d, out %d, ws %zu; nothing launched\n", NTOK * DM, (size_t)WS_END, n_in, n_in > 0 ? in_sizes[0] : -1, out_size, ws_size); grid = -1; return; }
        int dev = 0, cus = 0, per_cu = 0;
        if (hipGetDevice(&dev) != hipSuccess || hipDeviceGetAttribute(&cus, hipDeviceAttributeMultiprocessorCount, dev) != hipSuccess) { fprintf(stderr, "kernel_launch: device query failed\n"); grid = -1; return; }
        if (hipFuncSetAttribute((const void*)fwd_kernel, hipFuncAttributeMaxDynamicSharedMemorySize, LDS_BYTES) != hipSuccess) { fprintf(stderr, "kernel_launch: hipFuncSetAttribute failed\n"); grid = -1; return; }
        if (hipOccupancyMaxActiveBlocksPerMultiprocessor(&per_cu, (const void*)fwd_kernel, NTHR, LDS_BYTES) != hipSuccess || per_cu < 1)
            fprintf(stderr, "kernel_launch: note: occupancy query reports %d workgroups per CU\n", per_cu);
        (void)hipGetLastError();
        grid = cus;
    }
    if (grid < 0) return;
    if (hipMemsetAsync((char*)d_ws + WS_CTL, 0, CTL_ZERO_BYTES, stream) != hipSuccess) { fprintf(stderr, "kernel_launch: memset failed\n"); return; }
    Args a{};
    for (int i = 0; i < 31; ++i) a.in[i] = (const float*)d_in[i];
    a.out = (float*)d_out; a.ws = (unsigned char*)d_ws;
    hipLaunchKernelGGL(fwd_kernel, dim3(grid), dim3(NTHR), LDS_BYTES, stream, a);
    const hipError_t le = hipPeekAtLastError();
    if (le != hipSuccess) fprintf(stderr, "kernel_launch: launch failed: %s\n", hipGetErrorName(le));
}
```
